# Optimizing an MI355X kernel written in HIP

```python
import math
import jax, jax.numpy as jnp
from jax import lax
import numpy as np

D_MODEL = 1024
BATCH = 1
SEQ = 16384
DEPTH = 4

HEAD_DIM = 64
BLK = 128
NEG_INF = -1e30

SWA_WINDOW = 128
A_Q_HEADS = 4
A_KV_HEADS = 2
A_GROUP = A_Q_HEADS // A_KV_HEADS
A_COLS = (A_Q_HEADS + 2 * A_KV_HEADS) * HEAD_DIM

DILATED_PAIRS = ((128, 1), (512, 4), (2048, 16))
B_N_GROUPS = len(DILATED_PAIRS)
B_HEADS_PER_GROUP = 4
B_HEADS = B_N_GROUPS * B_HEADS_PER_GROUP
B_COLS = 3 * B_HEADS * HEAD_DIM
SEQ_ALIGN = BLK * max(d for _, d in DILATED_PAIRS)

C_HEADS = 8
C_NOPE = 64
C_ROPE = 32
C_V = 64
Q_LORA = 256
KV_LORA = 128
ROPE_THETA = 10000.0
C_COLS = Q_LORA + KV_LORA + C_ROPE

N_IN = A_COLS + B_COLS + C_COLS
D_MIX = A_Q_HEADS * HEAD_DIM + B_HEADS_PER_GROUP * HEAD_DIM + C_HEADS * C_V

N_BUCKETS = 32
MAX_DISTANCE = 2048
N_BIAS_HEADS = A_Q_HEADS + B_HEADS

N_GROUPS = 4
EXPERTS_PER_GROUP = 8
N_EXPERTS = N_GROUPS * EXPERTS_PER_GROUP
TOP_K = 2
D_EXPERT = 256
ROW_BLK = 256

DEEPNORM_ALPHA = (2 * DEPTH) ** 0.25
DEEPNORM_BETA = (8 * DEPTH) ** -0.25

kernel_name = "hymba_swa_dilated_mla_hmoe_deepnorm"


def layer_norm(x, g, b, eps=1e-5):
    xf = x.astype(jnp.float32)
    mu = xf.mean(-1, keepdims=True)
    var = jnp.square(xf - mu).mean(-1, keepdims=True)
    return ((xf - mu) * lax.rsqrt(var + eps) * g + b).astype(x.dtype)


def rms_norm(x, g, eps=1e-6):
    xf = x.astype(jnp.float32)
    return (xf * lax.rsqrt(jnp.mean(xf * xf, -1, keepdims=True) + eps) * g).astype(x.dtype)


def rotary(x, cos, sin):
    x1, x2 = jnp.split(x, 2, axis=-1)
    return jnp.concatenate([x1 * cos - x2 * sin, x1 * sin + x2 * cos], -1).astype(x.dtype)


def t5_bucket(dist):
    max_exact = N_BUCKETS // 2
    large = max_exact + (jnp.log(jnp.maximum(dist, 1).astype(jnp.float32) / max_exact)
                         / math.log(MAX_DISTANCE / max_exact) * (N_BUCKETS - max_exact)).astype(jnp.int32)
    return jnp.where(dist < max_exact, dist, jnp.minimum(large, N_BUCKETS - 1))


def head_bias(table_cols, dist):
    return table_cols[t5_bucket(jnp.maximum(dist, 0))].transpose(2, 0, 1).astype(jnp.float32)


def band_blocks(t, n_blocks):
    tb = t.reshape((t.shape[0], n_blocks, BLK) + t.shape[2:])
    prev = jnp.pad(tb[:, :-1], ((0, 0), (1, 0)) + ((0, 0),) * (tb.ndim - 2))
    return jnp.concatenate([prev, tb], axis=2)


def banded_logits(q, k, bias, max_dist):
    Bp, L = q.shape[:2]
    n = L // BLK
    qb = q.reshape((Bp, n, BLK) + q.shape[2:])
    kb = band_blocks(k, n)
    s = jnp.einsum('bnqhgd,bnkhd->bnhgqk', qb, kb).astype(jnp.float32) * (q.shape[-1] ** -0.5) + bias
    qi = jnp.arange(BLK)[:, None]
    kj = jnp.arange(2 * BLK)[None, :]
    dist = BLK + qi - kj
    kpos = jnp.arange(n)[:, None, None] * BLK + kj[None] - BLK
    mask = (dist >= 0) & (dist <= max_dist) & (kpos >= 0)
    return jnp.where(mask[None, :, None, None], s, NEG_INF)


def swa_sink_mixer(h_a, sink, bias_a):
    Bsz, T, _ = h_a.shape
    q, k, v = jnp.split(h_a, [A_Q_HEADS * HEAD_DIM, (A_Q_HEADS + A_KV_HEADS) * HEAD_DIM], axis=-1)
    q = q.reshape(Bsz, T, A_KV_HEADS, A_GROUP, HEAD_DIM)
    k = k.reshape(Bsz, T, A_KV_HEADS, HEAD_DIM)
    v = v.reshape(Bsz, T, A_KV_HEADS, HEAD_DIM)
    s = banded_logits(q, k, bias_a, SWA_WINDOW - 1)
    sink_b = sink.astype(jnp.float32).reshape(1, 1, A_KV_HEADS, A_GROUP, 1, 1)
    m = jnp.maximum(s.max(-1, keepdims=True), sink_b)
    e = jnp.exp(s - m)
    p = e / (e.sum(-1, keepdims=True) + jnp.exp(sink_b - m))
    o = jnp.einsum('bnhgqk,bnkhd->bnqhgd', p.astype(v.dtype), band_blocks(v, T // BLK))
    return o.reshape(Bsz, T, A_Q_HEADS * HEAD_DIM)


def dilated_group(q, k, v, bias, dil, steps):
    Bsz, Tp, H, hd = q.shape
    Ls = Tp // dil
    n = Ls // BLK

    def to_sub(t):
        return t.reshape(Bsz, Ls, dil, H, hd).transpose(0, 2, 1, 3, 4).reshape(Bsz * dil, Ls, H, hd)

    qs, ks, vs = to_sub(q), to_sub(k), to_sub(v)
    s = banded_logits(qs[:, :, :, None], ks, bias[:, None], steps)
    m = s.max(-1, keepdims=True)
    e = jnp.exp(s - m)
    l = e.sum(-1, keepdims=True)
    lse = (m + jnp.log(l))[..., 0]
    o = jnp.einsum('bnhgqk,bnkhd->bnqhgd', (e / l).astype(v.dtype), band_blocks(vs, n))
    o = o.reshape(Bsz, dil, Ls, H, hd).transpose(0, 2, 1, 3, 4).reshape(Bsz, Tp, H, hd)
    lse = lse.transpose(0, 1, 4, 2, 3).reshape(Bsz, dil, Ls, H).transpose(0, 2, 1, 3).reshape(Bsz, Tp, H)
    return o, lse


def dilated_mixer(h_b, bias_b):
    Bsz, T, _ = h_b.shape
    T_pad = -(-T // SEQ_ALIGN) * SEQ_ALIGN
    h_b = jnp.pad(h_b, ((0, 0), (0, T_pad - T), (0, 0)))
    shape5 = (Bsz, T_pad, B_N_GROUPS, B_HEADS_PER_GROUP, HEAD_DIM)
    q, k, v = [t.reshape(shape5) for t in jnp.split(h_b, 3, axis=-1)]
    outs, lses = [], []
    for g, (window, dil) in enumerate(DILATED_PAIRS):
        o_g, lse_g = dilated_group(q[:, :, g], k[:, :, g], v[:, :, g], bias_b[g], dil, window // dil)
        outs.append(o_g)
        lses.append(lse_g)
    w = jax.nn.softmax(jnp.stack(lses), axis=0)
    o = jnp.einsum('gbth,gbthd->bthd', w.astype(h_b.dtype), jnp.stack(outs))
    return o[:, :T].reshape(Bsz, T, B_HEADS_PER_GROUP * HEAD_DIM)


def mla_mixer(h_c, q_norm_g, kv_norm_g, w_uq, w_ukv, cos, sin):
    Bsz, T, _ = h_c.shape
    c_q, c_kv, k_rope = jnp.split(h_c, [Q_LORA, Q_LORA + KV_LORA], axis=-1)
    q = (rms_norm(c_q, q_norm_g) @ w_uq).reshape(Bsz, T, C_HEADS, C_NOPE + C_ROPE)
    kv = (rms_norm(c_kv, kv_norm_g) @ w_ukv).reshape(Bsz, T, C_HEADS, C_NOPE + C_V)
    q_nope, q_rope = jnp.split(q, [C_NOPE], axis=-1)
    k_nope, v = jnp.split(kv, [C_NOPE], axis=-1)
    q_rope = rotary(q_rope, cos[:, None], sin[:, None])
    k_rope = rotary(k_rope, cos, sin)
    n = T // BLK
    scale = (C_NOPE + C_ROPE) ** -0.5
    key_pos = jnp.arange(T)

    def to_blocks(t):
        return t.reshape((Bsz, n, BLK) + t.shape[2:]).swapaxes(0, 1)

    def one_block(args):
        qn, qr, blk = args
        s = (jnp.einsum('bqhd,bkhd->bhqk', qn, k_nope)
             + jnp.einsum('bqhd,bkd->bhqk', qr, k_rope)).astype(jnp.float32) * scale
        q_pos = blk * BLK + jnp.arange(BLK)
        s = jnp.where(key_pos[None, :] <= q_pos[:, None], s, NEG_INF)
        p = jax.nn.softmax(s, axis=-1)
        return jnp.einsum('bhqk,bkhd->bqhd', p.astype(v.dtype), v)

    o = lax.map(one_block, (to_blocks(q_nope), to_blocks(q_rope), jnp.arange(n)))
    return o.swapaxes(0, 1).reshape(Bsz, T, C_HEADS * C_V)


def hybrid_mixer(x, w_in, w_out, sink, bias_a, bias_b, q_norm_g, kv_norm_g, w_uq, w_ukv, cos, sin):
    h = x @ w_in
    h_a, h_b, h_c = jnp.split(h, [A_COLS, A_COLS + B_COLS], axis=-1)
    o_a = swa_sink_mixer(h_a, sink, bias_a)
    o_b = dilated_mixer(h_b, bias_b)
    o_c = mla_mixer(h_c, q_norm_g, kv_norm_g, w_uq, w_ukv, cos, sin)
    return jnp.concatenate([o_a, o_b, o_c], axis=-1) @ w_out


def hierarchical_moe(h, w_rg, b_rg, w_re, b_re, w_gate, w_up, w_down):
    Bsz, T, D = h.shape
    n_tok = Bsz * T
    x = h.reshape(n_tok, D)
    g_logits = (x @ w_rg).astype(jnp.float32) + b_rg
    g_prob = jax.nn.softmax(g_logits, axis=-1)
    grp = jnp.argmax(g_logits, axis=-1)
    p_grp = jnp.take_along_axis(g_prob, grp[:, None], axis=-1)
    e_all = jnp.einsum('nd,gde->nge', x, w_re).astype(jnp.float32) + b_re
    e_logits = jnp.take_along_axis(e_all, grp[:, None, None], axis=1)[:, 0]
    top_val, top_idx = lax.top_k(e_logits, TOP_K)
    gate = jax.nn.softmax(top_val, axis=-1) * p_grp
    expert_ids = grp[:, None] * EXPERTS_PER_GROUP + top_idx
    A = n_tok * TOP_K
    flat_e = expert_ids.reshape(A).astype(jnp.int32)
    flat_w = gate.reshape(A)
    flat_tok = jnp.arange(A, dtype=jnp.int32) // TOP_K
    order = jnp.argsort(flat_e)
    e_sorted = flat_e[order]
    counts = jnp.zeros((N_EXPERTS,), jnp.int32).at[flat_e].add(1)
    padded = ((counts + ROW_BLK - 1) // ROW_BLK) * ROW_BLK
    pad_end = jnp.cumsum(padded)
    pad_start = pad_end - padded
    start = jnp.cumsum(counts) - counts
    dest = pad_start[e_sorted] + (jnp.arange(A, dtype=jnp.int32) - start[e_sorted])
    n_blocks = A // ROW_BLK + N_EXPERTS
    P = n_blocks * ROW_BLK
    row_tok = jnp.full((P,), n_tok, jnp.int32).at[dest].set(flat_tok[order])
    row_w = jnp.zeros((P,), h.dtype).at[dest].set(flat_w[order].astype(h.dtype))
    block_expert = jnp.minimum(
        jnp.searchsorted(pad_end, jnp.arange(n_blocks) * ROW_BLK, side='right'), N_EXPERTS - 1)
    x_pad = jnp.concatenate([x, jnp.zeros((1, D), x.dtype)], axis=0)
    rows = x_pad[row_tok].reshape(n_blocks, ROW_BLK, D)

    def block_ffn(args):
        xb, e = args
        return (jax.nn.silu(xb @ w_gate[e]) * (xb @ w_up[e])) @ w_down[e]

    ys = lax.map(block_ffn, (rows, block_expert)).reshape(P, D) * row_w[:, None]
    out = jnp.zeros((n_tok + 1, D), ys.dtype).at[row_tok].add(ys)[:n_tok]
    return out.reshape(Bsz, T, D)


def setup_inputs(seed: int = 0) -> dict:
    key = jax.random.key(seed)
    ks = jax.random.split(key, 20)
    f32 = jnp.float32

    def nrm(k, shape, scale):
        return jax.random.normal(k, shape, f32) * scale

    return {
        "x": nrm(ks[0], (BATCH, SEQ, D_MODEL), 1.0),
        "w_in": nrm(ks[1], (DEPTH, D_MODEL, N_IN), D_MODEL ** -0.5),
        "w_out": nrm(ks[2], (DEPTH, D_MIX, D_MODEL), DEEPNORM_BETA * D_MIX ** -0.5),
        "sinks": nrm(ks[3], (DEPTH, A_Q_HEADS), 0.5),
        "rel_bias": nrm(ks[4], (N_BUCKETS, N_BIAS_HEADS), 0.1),
        "mla_q_norm": 1.0 + nrm(ks[5], (DEPTH, Q_LORA), 0.05),
        "mla_kv_norm": 1.0 + nrm(ks[6], (DEPTH, KV_LORA), 0.05),
        "w_uq": nrm(ks[7], (DEPTH, Q_LORA, C_HEADS * (C_NOPE + C_ROPE)), Q_LORA ** -0.5),
        "w_ukv": nrm(ks[8], (DEPTH, KV_LORA, C_HEADS * (C_NOPE + C_V)), KV_LORA ** -0.5),
        "ln1_g": 1.0 + nrm(ks[9], (DEPTH, D_MODEL), 0.05),
        "ln1_b": nrm(ks[10], (DEPTH, D_MODEL), 0.02),
        "w_route_group": nrm(ks[11], (DEPTH, D_MODEL, N_GROUPS), D_MODEL ** -0.5),
        "b_route_group": nrm(ks[12], (DEPTH, N_GROUPS), 0.01),
        "w_route_expert": nrm(ks[13], (DEPTH, N_GROUPS, D_MODEL, EXPERTS_PER_GROUP), D_MODEL ** -0.5),
        "b_route_expert": nrm(ks[14], (DEPTH, N_GROUPS, EXPERTS_PER_GROUP), 0.01),
        "w_expert_gate": nrm(ks[15], (DEPTH, N_EXPERTS, D_MODEL, D_EXPERT), D_MODEL ** -0.5),
        "w_expert_up": nrm(ks[16], (DEPTH, N_EXPERTS, D_MODEL, D_EXPERT), D_MODEL ** -0.5),
        "w_expert_down": nrm(ks[17], (DEPTH, N_EXPERTS, D_EXPERT, D_MODEL), DEEPNORM_BETA * D_EXPERT ** -0.5),
        "ln2_g": 1.0 + nrm(ks[18], (DEPTH, D_MODEL), 0.05),
        "ln2_b": nrm(ks[19], (DEPTH, D_MODEL), 0.02),
    }


def reference(x, w_in, w_out, sinks, rel_bias, mla_q_norm, mla_kv_norm, w_uq, w_ukv, ln1_g, ln1_b,
              w_route_group, b_route_group, w_route_expert, b_route_expert,
              w_expert_gate, w_expert_up, w_expert_down, ln2_g, ln2_b):
    T = x.shape[1]
    inv_freq = ROPE_THETA ** (-jnp.arange(0, C_ROPE, 2, dtype=jnp.float32) / C_ROPE)
    ang = jnp.arange(T, dtype=jnp.float32)[:, None] * inv_freq[None, :]
    cos, sin = jnp.cos(ang), jnp.sin(ang)
    dist = BLK + jnp.arange(BLK)[:, None] - jnp.arange(2 * BLK)[None, :]
    bias_a = head_bias(rel_bias[:, :A_Q_HEADS], dist).reshape(A_KV_HEADS, A_GROUP, BLK, 2 * BLK)
    bias_b = [head_bias(rel_bias[:, A_Q_HEADS + g * B_HEADS_PER_GROUP:A_Q_HEADS + (g + 1) * B_HEADS_PER_GROUP],
                        dist * dil)
              for g, (_, dil) in enumerate(DILATED_PAIRS)]
    for layer in range(DEPTH):
        y = hybrid_mixer(x, w_in[layer], w_out[layer], sinks[layer], bias_a, bias_b,
                         mla_q_norm[layer], mla_kv_norm[layer], w_uq[layer], w_ukv[layer], cos, sin)
        x = layer_norm(DEEPNORM_ALPHA * x + y, ln1_g[layer], ln1_b[layer])
        y = hierarchical_moe(x, w_route_group[layer], b_route_group[layer], w_route_expert[layer],
                             b_route_expert[layer], w_expert_gate[layer], w_expert_up[layer],
                             w_expert_down[layer])
        x = layer_norm(DEEPNORM_ALPHA * x + y, ln2_g[layer], ln2_b[layer])
    return x
```

```cpp
#include <hip/hip_runtime.h>
#include <cstdio>
#include <cstdint>

#define GAS __attribute__((address_space(1)))
#define LAS __attribute__((address_space(3)))
typedef unsigned short bf16;
typedef unsigned v4u __attribute__((ext_vector_type(4)));
typedef unsigned v2u __attribute__((ext_vector_type(2)));
typedef float f32x4 __attribute__((ext_vector_type(4)));
typedef float f32x2 __attribute__((ext_vector_type(2)));
typedef float f32x16 __attribute__((ext_vector_type(16)));
typedef short bf16x8 __attribute__((ext_vector_type(8)));
typedef short s16x4 __attribute__((ext_vector_type(4)));
typedef GAS unsigned gu32;
#define RLX_AGENT __ATOMIC_RELAXED, __HIP_MEMORY_SCOPE_AGENT
#define LDS_WAIT() asm volatile("s_waitcnt lgkmcnt(0)" ::: "memory")
#define VM_WAIT() asm volatile("s_waitcnt vmcnt(0)" ::: "memory")

constexpr int T = 16384, D = 1024, DEPTH = 4;
constexpr int NIN = 3232, NINP = 3328;
constexpr int HD = 64;
constexpr int A_Q = 0, A_K = 256, A_V = 384;
constexpr int B_Q = 512, B_K = 512 + 768, B_V = 512 + 1536;
constexpr int C_Q = 2816, C_KV = 3072, C_ROPE = 3200;
constexpr int NEXP = 32, DEXP = 256;
constexpr float ALPHA = 1.681792830507429f;
constexpr float LOG2E = 1.4426950408889634f;
constexpr float C_AB = 0.125f * LOG2E;
constexpr float C_MLA = 0.10206207261596577f * LOG2E;

__device__ __forceinline__ unsigned f2bf(float f) { unsigned u = __builtin_bit_cast(unsigned, f); return (u + 0x7fffu + ((u >> 16) & 1u)) >> 16; }
__device__ __forceinline__ unsigned pk2(float lo, float hi) { return f2bf(lo) | (f2bf(hi) << 16); }
__device__ __forceinline__ float bf2f(bf16 b) { return __builtin_bit_cast(float, (unsigned)b << 16); }
__device__ __forceinline__ unsigned cvt_pk_bf16(float lo, float hi) { unsigned r; asm volatile("v_cvt_pk_bf16_f32 %0, %1, %2" : "=v"(r) : "v"(lo), "v"(hi)); return r; }
__device__ __forceinline__ float wave_sum(float v) {
#pragma unroll
    for (int o = 1; o < 64; o <<= 1) v += __shfl_xor(v, o);
    return v;
}

#define XB_TMO      128
#define XB_XCNT(j)  (256  + 64 * (j))
#define XB_XSUB(j)  (1280 + 64 * (j))
#define XB_XGEN(j)  (2304 + 64 * (j))
#define XB_TOP      3328
#define XB_TOPGEN   3392
#define XCD_BAR_WORDS 3456
#define XB_SPIN_CAP (1u << 18)

__device__ __forceinline__ unsigned xb_ld(unsigned* p)              { return __hip_atomic_load(p, __ATOMIC_RELAXED, __HIP_MEMORY_SCOPE_AGENT); }
__device__ __forceinline__ unsigned xb_add(unsigned* p, unsigned v) { return __hip_atomic_fetch_add(p, v, __ATOMIC_RELAXED, __HIP_MEMORY_SCOPE_AGENT); }
__device__ __forceinline__ unsigned xb_xcc_id() { return (unsigned)__builtin_amdgcn_s_getreg((3 << 11) | 20) & 0xFu; }
#define XB_SPIN(cond, bar) do { unsigned _sp = 0; while (cond) { __builtin_amdgcn_s_sleep(1); \
    if ((++_sp & 255u) == 0u) { if (xb_ld(&(bar)[XB_TMO])) break; if (_sp > XB_SPIN_CAP) { atomicAdd(&(bar)[XB_TMO], 1u); break; } } } } while (0)

struct XcdBarrier {
    unsigned* bar; unsigned x;
    volatile LAS unsigned* st;
};
__device__ __forceinline__ XcdBarrier xcd_barrier_post(unsigned* bar, volatile LAS unsigned* st) {
    XcdBarrier b; b.bar = bar; b.x = xb_xcc_id(); b.st = st;
    if (threadIdx.x == 0) (void)xb_add(&bar[XB_XCNT(b.x)], 1u);
    return b;
}
__device__ __forceinline__ void xcd_barrier_complete(unsigned* bar, unsigned x, unsigned& nloc, unsigned& nx) {
    const unsigned G = gridDim.x * gridDim.y * gridDim.z;
    unsigned sum, cnt, mine, sp = 0u;
    for (;;) {
        sum = 0u; cnt = 0u; mine = 0u;
#pragma unroll
        for (unsigned j = 0; j < 16; ++j) { const unsigned c = xb_ld(&bar[XB_XCNT(j)]); sum += c; cnt += (c > 0u) ? 1u : 0u; mine = (j == x) ? c : mine; }
        if (sum == G) break;
        __builtin_amdgcn_s_sleep(1);
        if ((++sp & 255u) == 0u) { if (xb_ld(&bar[XB_TMO])) break; if (sp > XB_SPIN_CAP) { atomicAdd(&bar[XB_TMO], 1u); break; } }
    }
    nloc = mine > 0u ? mine : 1u; nx = cnt > 0u ? cnt : 1u;
}
__device__ __forceinline__ void xcd_barrier(const XcdBarrier& b) {
    asm volatile("s_waitcnt vmcnt(0)" ::: "memory");
    __syncthreads();
    if (threadIdx.x == 0) {
        unsigned* bar = b.bar;
        __builtin_amdgcn_s_waitcnt(0);
        unsigned nloc = b.st[0], nx = b.st[1];
        if (nloc == 0u) { xcd_barrier_complete(bar, b.x, nloc, nx); b.st[0] = nloc; b.st[1] = nx; }
        const unsigned old = xb_add(&bar[XB_XSUB(b.x)], 1u);
        const unsigned gen = old / nloc;
        if (old + 1u == (gen + 1u) * nloc) {
            __builtin_amdgcn_fence(__ATOMIC_RELEASE, "agent");
            asm volatile("s_waitcnt vmcnt(0)" ::: "memory");
            const unsigned og = xb_add(&bar[XB_TOP], 1u);
            const unsigned tg = og / nx;
            if (og + 1u == (tg + 1u) * nx) xb_add(&bar[XB_TOPGEN], 1u);
            else XB_SPIN(xb_ld(&bar[XB_TOPGEN]) == tg, bar);
            __builtin_amdgcn_fence(__ATOMIC_ACQUIRE, "agent");
            xb_add(&bar[XB_XGEN(b.x)], 1u);
            asm volatile("s_waitcnt vmcnt(0)" ::: "memory");
        } else {
            XB_SPIN(xb_ld(&bar[XB_XGEN(b.x)]) == gen, bar);
            __builtin_amdgcn_fence(__ATOMIC_ACQUIRE, "agent");
            asm volatile("s_waitcnt vmcnt(0)" ::: "memory");
        }
    }
    __syncthreads();
}
namespace pg8 {
constexpr int BM = 256, BK = 64, HALF = 128, HTB = HALF * BK * 2  , STAGE_BYTES = 8 * HTB, NXCD = 8, WGM = 8;

__host__ __device__ __forceinline__ int lds_byte(int r, int c) { const int st = (r >> 4) * 2 + (c >> 5), rr = r & 15, cc = c & 31, ob = rr * 64 + cc * 2; return st * 1024 + (ob ^ (((ob >> 9) & 1) << 5)); }
__host__ __device__ __forceinline__ void stage_rc(int b, int& R, int& C) { const int st = b / 1024, sb = b % 1024, swz = sb ^ (((sb >> 9) & 1) << 5); R = (st >> 1) * 16 + swz / 64; C = (st & 1) * 32 + (swz % 64) / 2; }
__host__ __device__ __forceinline__ int perm32(int rho) { const int n = rho >> 4, i = rho & 15; return 8 * (i >> 2) + 4 * n + (i & 3); }

struct Unit { int pm, pn, e, lrt; };
struct Gemm { const bf16* A; const bf16* Bt; int lda, ldb, K; };

struct StaticOrder {
    static constexpr bool GATHER = false;
    int nM, nN, nwg, G, c;
    __device__ void init(int M, int N, int G_, int c_) { nM = M / BM; nN = N / BM; nwg = nM * nN; G = G_; c = c_; }
    __device__ bool next(int i, Unit& u) const {
        const long L = (long)i * G + c; if (L >= nwg) return false;
        int wgid = (int)L; { const int q = nwg / NXCD, r = nwg % NXCD, xcd = wgid % NXCD, off = wgid / NXCD; wgid = (xcd < r ? xcd * (q + 1) : r * (q + 1) + (xcd - r) * q) + off; }
        const int nig = WGM * nN, gid = wgid / nig, fm = gid * WGM, gsz = (nM - fm) < WGM ? (nM - fm) : WGM;
        u.pm = fm + ((wgid % nig) % gsz); u.pn = (wgid % nig) / gsz; u.e = 0; u.lrt = 0; return true;
    }
    __device__ __forceinline__ int arow(const Unit&, int) const { return 0; }
};

template <class Epi, class Sched, bool ALIGN_EPI>
__device__ __forceinline__ void gemm_phase(LAS unsigned char* lds, const Gemm g, const Sched& S, const Epi& E) {
    int tid = threadIdx.x; asm volatile("" : "+v"(tid));
    const int wid = __builtin_amdgcn_readfirstlane(tid >> 6), lane = tid & 63, wr = wid >> 2, wc = wid & 3, fr = lane & 15, fq = lane >> 4;
    int K = g.K; asm volatile("" : "+s"(K));
    const int nt = K / BK;
    int RA[2], CA[2];
    unsigned voffB[2];
#pragma unroll
    for (int i = 0; i < 2; ++i) { int R, C; stage_rc(tid * 16 + i * 8192, R, C); const int Rb = Epi::PERM ? ((R & ~31) + perm32(R & 31)) : R;
        RA[i] = R; CA[i] = C; voffB[i] = (unsigned)(Rb * g.ldb + C) * 2u; }
    const size_t kstep = (size_t)(BK * 2);
    const size_t hstepB = (size_t)HALF * g.ldb * 2, tstepB = 2 * hstepB;
    const unsigned ldsw = (unsigned)wid * 1024u;
    const int aoff = lds_byte(wr * 64 + fr, fq * 8), boff = lds_byte(wc * 32 + fr, fq * 8);
#define PG8_SA(b, h) (((b) * 2 + (h)) * HTB)
#define PG8_SB(b, h) ((4 + (b) * 2 + (h)) * HTB)
#define PG8_STAGE(bufoff, gbase, voff) do { _Pragma("unroll") for (int _i = 0; _i < 2; ++_i) \
        __builtin_amdgcn_global_load_lds((const unsigned*)((const char*)(gbase) + (voff)[_i]), (LAS unsigned*)(lds + (bufoff) + ldsw + _i * 8192), 16, 0, 0); } while (0)
#define PG8_LDA(dst, b, h) do { _Pragma("unroll") for (int m = 0; m < 4; ++m) _Pragma("unroll") for (int k = 0; k < 2; ++k) dst[m][k] = *(const LAS bf16x8*)(lds + PG8_SA(b, h) + aoff + m * 2048 + k * 1024); } while (0)
#define PG8_LDB(dst, b, h) do { _Pragma("unroll") for (int n = 0; n < 2; ++n) _Pragma("unroll") for (int k = 0; k < 2; ++k) dst[n][k] = *(const LAS bf16x8*)(lds + PG8_SB(b, h) + boff + n * 2048 + k * 1024); } while (0)
#define PG8_MMA(ai, bj, At, Bt) do { __builtin_amdgcn_s_setprio(1); _Pragma("unroll") for (int m = 0; m < 4; ++m) _Pragma("unroll") for (int n = 0; n < 2; ++n) _Pragma("unroll") for (int k = 0; k < 2; ++k) \
        acc[ai][bj][m][n] = __builtin_amdgcn_mfma_f32_16x16x32_bf16(Bt[n][k], At[m][k], acc[ai][bj][m][n], 0, 0, 0); __builtin_amdgcn_s_setprio(0); } while (0)
#define PG8_WAIT_V(n) asm volatile("s_waitcnt vmcnt(" #n ")" ::: "memory")
#define PG8_WAIT_L(n) asm volatile("s_waitcnt lgkmcnt(" #n ")" ::: "memory")
#define PG8_BAR __builtin_amdgcn_s_barrier()
#define PG8_SCHED __builtin_amdgcn_sched_barrier(0)
#define PG8_AOFFS(dst, un) do { _Pragma("unroll") for (int _h = 0; _h < 2; ++_h) _Pragma("unroll") for (int _i = 0; _i < 2; ++_i) { \
        const int _row = S.arow(un, _h * HALF + RA[_i]); dst[_h][_i] = (unsigned)((size_t)_row * g.lda + CA[_i]) * 2u; } } while (0)
#define PG8_STAGE_A(bufoff, gbase, h, offs) do { _Pragma("unroll") for (int _i = 0; _i < 2; ++_i) { \
        const char* _src = Sched::GATHER ? (const char*)(gbase) + (offs)[h][_i] : (const char*)(gbase) + (size_t)(h) * hstepA + voffA[_i]; \
        __builtin_amdgcn_global_load_lds((const unsigned*)_src, (LAS unsigned*)(lds + (bufoff) + ldsw + _i * 8192), 16, 0, 0); } } while (0)
    const size_t hstepA = (size_t)HALF * g.lda * 2, tstepA = 2 * hstepA;
    unsigned voffA[2];
#pragma unroll
    for (int i = 0; i < 2; ++i) voffA[i] = (unsigned)(RA[i] * g.lda + CA[i]) * 2u;
    Unit cur, nxt; int ui = 0;
    if (!S.next(0, cur)) return;
    f32x4 acc[2][2][4][2];
#pragma unroll
    for (int a = 0; a < 2; ++a)
#pragma unroll
        for (int b = 0; b < 2; ++b)
#pragma unroll
            for (int m = 0; m < 4; ++m)
#pragma unroll
                for (int n = 0; n < 2; ++n) acc[a][b][m][n] = (f32x4){0.f, 0.f, 0.f, 0.f};
    bf16x8 At[4][2], B0[2][2], B1[2][2];
    unsigned offA[2][2] = {{0u, 0u}, {0u, 0u}}, noffA[2][2] = {{0u, 0u}, {0u, 0u}};
    if constexpr (Sched::GATHER) { PG8_AOFFS(offA, cur); }
    const char* cA = Sched::GATHER ? (const char*)g.A : (const char*)g.A + (size_t)cur.pm * tstepA;
    const char* cB = (const char*)g.Bt + (size_t)cur.pn * tstepB;
    PG8_STAGE(PG8_SB(0, 0), cB, voffB); PG8_STAGE(PG8_SB(0, 1), cB + hstepB, voffB); PG8_STAGE_A(PG8_SA(0, 0), cA, 0, offA); PG8_STAGE_A(PG8_SA(0, 1), cA, 1, offA);
    if (wr == 1) PG8_BAR;
    PG8_WAIT_V(2); PG8_BAR;
    PG8_STAGE(PG8_SB(1, 0), cB + kstep, voffB); PG8_STAGE_A(PG8_SA(1, 0), cA + kstep, 0, offA); PG8_STAGE(PG8_SB(1, 1), cB + hstepB + kstep, voffB);
    PG8_WAIT_V(6); PG8_BAR;
    for (;;) {
        const bool has_next = S.next(ui + 1, nxt);
        if constexpr (Sched::GATHER) {
            if (has_next) { PG8_AOFFS(noffA, nxt); }
            else {
#pragma unroll
                for (int h = 0; h < 2; ++h)
#pragma unroll
                    for (int i = 0; i < 2; ++i) noffA[h][i] = offA[h][i];
            }
        }
        const char* nA = Sched::GATHER ? cA : (has_next ? (const char*)g.A + (size_t)nxt.pm * tstepA : cA);
        const char* nB = has_next ? (const char*)g.Bt + (size_t)nxt.pn * tstepB : cB;
#pragma unroll 1
        for (int t = 0; t < nt; t += 2) {
            const bool last = (t == nt - 2);
            const char* a1 = cA + (size_t)(t + 1) * kstep;
            const char* a2 = last ? nA : cA + (size_t)(t + 2) * kstep; const char* b2 = last ? nB : cB + (size_t)(t + 2) * kstep;
            const char* a3 = a2 + kstep; const char* b3 = b2 + kstep;
            unsigned o2[2][2] = {{0u, 0u}, {0u, 0u}};
            if constexpr (Sched::GATHER) {
#pragma unroll
                for (int h = 0; h < 2; ++h)
#pragma unroll
                    for (int i = 0; i < 2; ++i) o2[h][i] = last ? noffA[h][i] : offA[h][i];
            }
            PG8_LDB(B0, 0, 0); PG8_LDB(B1, 0, 1); PG8_SCHED; PG8_LDA(At, 0, 0); PG8_STAGE_A(PG8_SA(1, 1), a1, 1, offA);
            PG8_WAIT_V(8); PG8_WAIT_L(0); PG8_BAR; PG8_MMA(0, 0, At, B0); PG8_MMA(0, 1, At, B1); PG8_BAR; PG8_SCHED;
            PG8_LDA(At, 0, 1); PG8_STAGE(PG8_SB(0, 0), b2, voffB); PG8_STAGE(PG8_SB(0, 1), b2 + hstepB, voffB); PG8_STAGE_A(PG8_SA(0, 0), a2, 0, o2);
            PG8_WAIT_V(8); PG8_WAIT_L(0); PG8_BAR; PG8_MMA(1, 0, At, B0); PG8_MMA(1, 1, At, B1); PG8_BAR; PG8_SCHED;
            PG8_LDB(B0, 1, 0); PG8_LDB(B1, 1, 1); PG8_SCHED; PG8_LDA(At, 1, 0); PG8_STAGE_A(PG8_SA(0, 1), a2, 1, o2);
            PG8_WAIT_V(8); PG8_WAIT_L(0); PG8_BAR; PG8_MMA(0, 0, At, B0); PG8_MMA(0, 1, At, B1); PG8_BAR; PG8_SCHED;
            PG8_LDA(At, 1, 1); PG8_STAGE(PG8_SB(1, 0), b3, voffB); PG8_STAGE(PG8_SB(1, 1), b3 + hstepB, voffB); PG8_STAGE_A(PG8_SA(1, 0), a3, 0, o2);
            PG8_WAIT_V(8); PG8_WAIT_L(0); PG8_BAR; PG8_MMA(1, 0, At, B0); PG8_MMA(1, 1, At, B1); PG8_BAR; PG8_SCHED;
        }
        if constexpr (ALIGN_EPI) { if (wr == 0) PG8_BAR; }
        E(acc, cur, wr, wc, fr, fq);
        if (!has_next) break;
#pragma unroll
        for (int a = 0; a < 2; ++a)
#pragma unroll
            for (int b = 0; b < 2; ++b)
#pragma unroll
                for (int m = 0; m < 4; ++m)
#pragma unroll
                    for (int n = 0; n < 2; ++n) acc[a][b][m][n] = (f32x4){0.f, 0.f, 0.f, 0.f};
        cur = nxt; cA = nA; cB = nB; ++ui;
        if constexpr (Sched::GATHER) {
#pragma unroll
            for (int h = 0; h < 2; ++h)
#pragma unroll
                for (int i = 0; i < 2; ++i) offA[h][i] = noffA[h][i];
        }
        if constexpr (ALIGN_EPI) { if (wr == 1) PG8_BAR; }
    }
    PG8_WAIT_V(0);
    if constexpr (!ALIGN_EPI) { if (wr == 0) PG8_BAR; }
    PG8_BAR;
#undef PG8_SA
#undef PG8_SB
#undef PG8_STAGE
#undef PG8_LDA
#undef PG8_LDB
#undef PG8_MMA
#undef PG8_WAIT_V
#undef PG8_WAIT_L
#undef PG8_BAR
#undef PG8_SCHED
#undef PG8_AOFFS
#undef PG8_STAGE_A
}
}
namespace pg8 {
typedef const f32x4 (&AccRef)[2][2][4][2];

struct EpiGemm1 {
    static constexpr bool PERM = false;
    bf16* H; bf16* KC; float* ssq; const float* cs; const float* sn;
    __device__ __forceinline__ void operator()(AccRef acc, const Unit& u, int wr, int wc, int fr, int fq) const {
        const int pn = u.pn;
        const float sc = (pn == 0 || (pn >= 2 && pn <= 4)) ? C_AB : 1.0f;
#pragma unroll
        for (int ai = 0; ai < 2; ++ai)
#pragma unroll
            for (int m = 0; m < 4; ++m) {
                const int r = u.pm * BM + ai * HALF + wr * 64 + m * 16 + fr;
                bf16* hrow = H + (size_t)r * NINP + pn * BM + wc * 32 + 4 * fq;
                const int nbj = (pn == 12) ? 1 : 2;
#pragma unroll
                for (int bj = 0; bj < 2; ++bj) if (bj < nbj)
#pragma unroll
                    for (int n = 0; n < 2; ++n) { const f32x4 v = acc[ai][bj][m][n] * sc; v2u w; w.x = cvt_pk_bf16(v[0], v[1]); w.y = cvt_pk_bf16(v[2], v[3]);
                        *(v2u*)(hrow + bj * HALF + n * 16) = w; }
                if (pn >= 11) {
                    float s = 0.f;
#pragma unroll
                    for (int bj = 0; bj < 2; ++bj) if (bj < nbj)
#pragma unroll
                        for (int n = 0; n < 2; ++n) { const f32x4 v = acc[ai][bj][m][n]; s += (v[0] * v[0] + v[1] * v[1]) + (v[2] * v[2] + v[3] * v[3]); }
                    s += __shfl_xor(s, 16); s += __shfl_xor(s, 32);
                    if (fq == 0) ssq[(size_t)r * 8 + (pn - 11) * 4 + wc] = s;
                    if (pn == 12 && wc == 0) {
                        const f32x4 x1 = acc[ai][1][m][0], x2 = acc[ai][1][m][1];
                        const f32x4 c = *(const f32x4*)(cs + (size_t)r * 16 + 4 * fq), sv = *(const f32x4*)(sn + (size_t)r * 16 + 4 * fq);
                        const f32x4 o1 = x1 * c - x2 * sv, o2 = x1 * sv + x2 * c;
                        v2u w1, w2; w1.x = cvt_pk_bf16(o1[0], o1[1]); w1.y = cvt_pk_bf16(o1[2], o1[3]); w2.x = cvt_pk_bf16(o2[0], o2[1]); w2.y = cvt_pk_bf16(o2[2], o2[3]);
                        bf16* kr = KC + (size_t)r * 768 + 64 + 4 * fq;
#pragma unroll
                        for (int h = 0; h < 8; ++h) { *(v2u*)(kr + h * 96) = w1; *(v2u*)(kr + h * 96 + 16) = w2; }
                    }
                }
            }
    }
};

struct EpiUpQ {
    static constexpr bool PERM = false;
    bf16* QC; const float* ssq; const float* cs; const float* sn;
    __device__ __forceinline__ void operator()(AccRef acc, const Unit& u, int wr, int wc, int fr, int fq) const {
#pragma unroll
        for (int ai = 0; ai < 2; ++ai)
#pragma unroll
            for (int m = 0; m < 4; ++m) {
                const int r = u.pm * BM + ai * HALF + wr * 64 + m * 16 + fr;
                const f32x4 sq = *(const f32x4*)(ssq + (size_t)r * 8);
                const float rs = C_MLA / sqrtf(((sq[0] + sq[1]) + (sq[2] + sq[3])) * (1.0f / 256.0f) + 1e-6f);
#pragma unroll
                for (int bj = 0; bj < 2; ++bj) {
                    const int cb = u.pn * BM + bj * HALF + wc * 32;
                    f32x4 v0 = acc[ai][bj][m][0] * rs, v1 = acc[ai][bj][m][1] * rs;
                    if (cb % 96 == 64) {
                        const f32x4 c = *(const f32x4*)(cs + (size_t)r * 16 + 4 * fq), sv = *(const f32x4*)(sn + (size_t)r * 16 + 4 * fq);
                        const f32x4 o1 = v0 * c - v1 * sv, o2 = v0 * sv + v1 * c; v0 = o1; v1 = o2;
                    }
                    v2u w0, w1; w0.x = cvt_pk_bf16(v0[0], v0[1]); w0.y = cvt_pk_bf16(v0[2], v0[3]); w1.x = cvt_pk_bf16(v1[0], v1[1]); w1.y = cvt_pk_bf16(v1[2], v1[3]);
                    bf16* q = QC + (size_t)r * 768 + cb + 4 * fq;
                    *(v2u*)q = w0; *(v2u*)(q + 16) = w1;
                }
            }
    }
};

struct EpiUpKV {
    static constexpr bool PERM = true;
    bf16* KC; bf16* VC; const float* ssq;
    __device__ __forceinline__ void operator()(AccRef acc, const Unit& u, int wr, int wc, int fr, int fq) const {
#pragma unroll
        for (int ai = 0; ai < 2; ++ai)
#pragma unroll
            for (int m = 0; m < 4; ++m) {
                const int r = u.pm * BM + ai * HALF + wr * 64 + m * 16 + fr;
                const f32x4 sq = *(const f32x4*)(ssq + (size_t)r * 8 + 4);
                const float rs = 1.0f / sqrtf(((sq[0] + sq[1]) + (sq[2] + sq[3])) * (1.0f / 128.0f) + 1e-6f);
#pragma unroll
                for (int bj = 0; bj < 2; ++bj) {
                    const int head = u.pn * 2 + bj, off = wc * 32 + 8 * fq;
                    const f32x4 v0 = acc[ai][bj][m][0] * rs, v1 = acc[ai][bj][m][1] * rs;
                    v4u w; w.x = cvt_pk_bf16(v0[0], v0[1]); w.y = cvt_pk_bf16(v0[2], v0[3]); w.z = cvt_pk_bf16(v1[0], v1[1]); w.w = cvt_pk_bf16(v1[2], v1[3]);
                    if (wc < 2) *(v4u*)(KC + (size_t)r * 768 + head * 96 + off) = w;
                    else        *(v4u*)(VC + (size_t)r * 512 + head * 64 + (off - 64)) = w;
                }
            }
    }
};

struct EpiOut {
    static constexpr bool PERM = false;
    const float* X; float* Z;
    __device__ __forceinline__ void operator()(AccRef acc, const Unit& u, int wr, int wc, int fr, int fq) const {
#pragma unroll
        for (int ai = 0; ai < 2; ++ai)
#pragma unroll
            for (int m = 0; m < 4; ++m) {
                const size_t off = (size_t)(u.pm * BM + ai * HALF + wr * 64 + m * 16 + fr) * D + u.pn * BM + wc * 32 + 4 * fq;
#pragma unroll
                for (int bj = 0; bj < 2; ++bj)
#pragma unroll
                    for (int n = 0; n < 2; ++n) { const f32x4 xv = *(const f32x4*)(X + off + bj * HALF + n * 16);
                        *(f32x4*)(Z + off + bj * HALF + n * 16) = xv * ALPHA + acc[ai][bj][m][n]; }
            }
    }
};

struct MoeOrder {
    static constexpr bool GATHER = true;
    const volatile LAS int* tstart;
    const volatile LAS int* cnts;
    const int* list_tok;
    int npn, G, c;
    __device__ bool next(int i, Unit& u) const {
        const long L = (long)i * G + c; const int nun = tstart[32] * npn; if (L >= nun) return false;
        const int rt = (int)L / npn, p = (int)L % npn; int e = 0;
        for (; e < 31; ++e) if (tstart[e + 1] > rt) break;
        u.pm = rt; u.pn = e * npn + p; u.e = e; u.lrt = rt - tstart[e]; return true;
    }
    __device__ __forceinline__ int arow(const Unit& u, int r) const { const int idx = u.lrt * BM + r; return idx < cnts[u.e] ? list_tok[(size_t)u.e * T + idx] : 0; }
};
struct MoeOrderDense : MoeOrder { static constexpr bool GATHER = false; };

struct EpiMoe1 {
    static constexpr bool PERM = true;
    bf16* HM;
    __device__ __forceinline__ void operator()(AccRef acc, const Unit& u, int wr, int wc, int fr, int fq) const {
        const int pl = u.pn & 1;
#pragma unroll
        for (int ai = 0; ai < 2; ++ai)
#pragma unroll
            for (int m = 0; m < 4; ++m) {
                const int r = u.pm * BM + ai * HALF + wr * 64 + m * 16 + fr;
                float o[8];
#pragma unroll
                for (int n = 0; n < 2; ++n)
#pragma unroll
                    for (int j = 0; j < 4; ++j) { const float gt = acc[ai][0][m][n][j], up = acc[ai][1][m][n][j];
                        o[n * 4 + j] = gt * __builtin_amdgcn_rcpf(1.0f + __builtin_amdgcn_exp2f(-gt * LOG2E)) * up; }
                v4u w; w.x = cvt_pk_bf16(o[0], o[1]); w.y = cvt_pk_bf16(o[2], o[3]); w.z = cvt_pk_bf16(o[4], o[5]); w.w = cvt_pk_bf16(o[6], o[7]);
                *(v4u*)(HM + (size_t)r * DEXP + pl * HALF + wc * 32 + 8 * fq) = w;
            }
    }
};
struct EpiMoe2 {
    static constexpr bool PERM = true;
    bf16* YS; const int* list_dst; const float* list_w; const volatile LAS int* cnts;
    __device__ __forceinline__ void operator()(AccRef acc, const Unit& u, int wr, int wc, int fr, int fq) const {
        const int pl = u.pn & 3; const int cnt = cnts[u.e];
#pragma unroll
        for (int ai = 0; ai < 2; ++ai)
#pragma unroll
            for (int m = 0; m < 4; ++m) {
                const int idx = u.lrt * BM + ai * HALF + wr * 64 + m * 16 + fr;
                if (idx < cnt) {
                    const int dst = list_dst[(size_t)u.e * T + idx]; const float wg = list_w[(size_t)u.e * T + idx];
                    bf16* y = YS + (size_t)dst * D + pl * BM + wc * 32 + 8 * fq;
#pragma unroll
                    for (int bj = 0; bj < 2; ++bj) { const f32x4 v0 = acc[ai][bj][m][0] * wg, v1 = acc[ai][bj][m][1] * wg;
                        v4u w; w.x = cvt_pk_bf16(v0[0], v0[1]); w.y = cvt_pk_bf16(v0[2], v0[3]); w.z = cvt_pk_bf16(v1[0], v1[1]); w.w = cvt_pk_bf16(v1[2], v1[3]);
                        *(v4u*)(y + bj * HALF) = w; }
                }
            }
    }
};
}
namespace att {
__device__ __forceinline__ int crow(int r, int hi) { return (r & 3) + 8 * (r >> 2) + 4 * hi; }
typedef short v4i16_t __attribute__((ext_vector_type(4)));
__device__ __forceinline__ s16x4 vtr(const LAS unsigned char* p) { return __builtin_bit_cast(s16x4, __builtin_amdgcn_ds_read_tr16_b64_v4i16((LAS v4i16_t*)p)); }

struct AttnP {
    const bf16* Q; long qstr;
    const bf16* K; long kstr;
    const bf16* V; long vstr;
    bf16* O; long ostr;
    float* LSE; long lstr;
    int q0;
    int k0;
    int nt;
    float m_init, l_init;
    int W;
};

template <int DQK> struct Lay { static constexpr int KB = DQK / 8 * 1024, VOFF = KB, BOFF = KB + 8192, BYTES = BOFF + 1024; };

template <int DQK, int MODE>
__device__ __forceinline__ void attn_unit(const AttnP& a, LAS unsigned char* lds) {
    typedef Lay<DQK> L;
    constexpr int NS = DQK / 16;
    int tid = threadIdx.x; asm volatile("" : "+v"(tid));
    const int lane = tid & 63, r32 = lane & 31, hi = lane >> 5; const int wid = __builtin_amdgcn_readfirstlane(tid >> 6);
    const LAS float* btab = (const LAS float*)(lds + L::BOFF);
    const int qs = a.q0 + wid * 32 + r32;
    const int qa = a.q0 + wid * 32, qb = qa + 31;
    const int W = a.W;
    bf16x8 qr[NS];
    { const bf16* qp = a.Q + (long)qs * a.qstr + hi * 8;
#pragma unroll
      for (int s = 0; s < NS; ++s) qr[s] = *(const bf16x8*)(qp + s * 16); }
    float m_run = a.m_init, l_run = (hi == 0) ? a.l_init : 0.f;
    f32x16 o0 = {}, o1 = {};
    const LAS unsigned char* vb = lds + L::VOFF + ((lane >> 4) & 1) * 32 + (lane & 3) * 8 + (4 * hi + ((lane & 15) >> 2)) * 64;
    const LAS unsigned char* kb = lds + hi * 1024 + r32 * 16;
    for (int t = 0; t < a.nt; ++t) {
        const int ka = a.k0 + t * 64;
        __syncthreads();
        { int kr = ka + lane; kr = kr < 0 ? 0 : kr;
          const bf16* ksrc = a.K + (long)kr * a.kstr;
#pragma unroll
          for (int c0 = 0; c0 < NS * 2; c0 += 8) { const int c = c0 + wid; if (c < NS * 2)
              __builtin_amdgcn_global_load_lds((const unsigned*)(ksrc + c * 8), (LAS unsigned*)(lds + c * 1024), 16, 0, 0); }
          int vr = ka + 16 * (wid & 3) + (lane >> 2); vr = vr < 0 ? 0 : vr;
          const bf16* vsrc = a.V + (long)vr * a.vstr + (wid >> 2) * 32 + (lane & 3) * 8;
          __builtin_amdgcn_global_load_lds((const unsigned*)vsrc, (LAS unsigned*)(lds + L::VOFF + wid * 1024), 16, 0, 0); }
        VM_WAIT();
        __syncthreads();
        const int kz = ka + 63;
        bool any, full;
        if (MODE == 0) { any = (kz >= qa - W) && (ka <= qb) && (kz >= 0); full = (ka >= 0) && (ka >= qb - W) && (kz <= qa); }
        else           { any = (ka <= qb);                               full = (kz <= qa); }
        if (!any) continue;
        f32x16 p0 = {}, p1 = {};
#pragma unroll
        for (int s = 0; s < NS; ++s) {
            const bf16x8 k0f = *(const LAS bf16x8*)(kb + s * 2048), k1f = *(const LAS bf16x8*)(kb + s * 2048 + 512);
            p0 = __builtin_amdgcn_mfma_f32_32x32x16_bf16(k0f, qr[s], p0, 0, 0, 0);
            p1 = __builtin_amdgcn_mfma_f32_32x32x16_bf16(k1f, qr[s], p1, 0, 0, 0);
        }
        if (MODE == 0) {
#pragma unroll
            for (int r = 0; r < 16; ++r) {
                const int k_0 = ka + crow(r, hi), k_1 = k_0 + 32; const int d0 = qs - k_0, d1 = qs - k_1;
                const int c0 = d0 < 0 ? 0 : (d0 > W ? W : d0), c1 = d1 < 0 ? 0 : (d1 > W ? W : d1);
                const float b0 = btab[c0], b1 = btab[c1];
                p0[r] = (k_0 >= 0 && d0 >= 0 && d0 <= W) ? p0[r] + b0 : -INFINITY;
                p1[r] = (k_1 >= 0 && d1 >= 0 && d1 <= W) ? p1[r] + b1 : -INFINITY;
            }
        } else if (!full) {
#pragma unroll
            for (int r = 0; r < 16; ++r) { const int k_0 = ka + crow(r, hi); if (k_0 > qs) p0[r] = -INFINITY; if (k_0 + 32 > qs) p1[r] = -INFINITY; }
        }
        float mx = p0[0];
#pragma unroll
        for (int r = 1; r < 16; ++r) mx = fmaxf(mx, p0[r]);
#pragma unroll
        for (int r = 0; r < 16; ++r) mx = fmaxf(mx, p1[r]);
        { auto rr = __builtin_amdgcn_permlane32_swap(__float_as_uint(mx), __float_as_uint(mx), false, false); mx = fmaxf(__uint_as_float(rr[0]), __uint_as_float(rr[1])); }
        const float m_new = fmaxf(m_run, mx);
        const float m_safe = (m_new == -INFINITY) ? 0.f : m_new;
        const float alpha = __builtin_amdgcn_exp2f(m_run - m_safe);
        m_run = m_new;
        float ls = 0.f;
#pragma unroll
        for (int r = 0; r < 16; ++r) { p0[r] = __builtin_amdgcn_exp2f(p0[r] - m_safe); p1[r] = __builtin_amdgcn_exp2f(p1[r] - m_safe); ls += p0[r] + p1[r]; }
        l_run = l_run * alpha + ls;
#pragma unroll
        for (int r = 0; r < 16; ++r) { o0[r] *= alpha; o1[r] *= alpha; }
        bf16x8 pf[4];
#define ATT_PK(P, B) __builtin_bit_cast(bf16x8, (v4u){cvt_pk_bf16(P[B], P[B + 1]), cvt_pk_bf16(P[B + 2], P[B + 3]), cvt_pk_bf16(P[B + 4], P[B + 5]), cvt_pk_bf16(P[B + 6], P[B + 7])})
        pf[0] = ATT_PK(p0, 0); pf[1] = ATT_PK(p0, 8); pf[2] = ATT_PK(p1, 0); pf[3] = ATT_PK(p1, 8);
#undef ATT_PK
#pragma unroll
        for (int ks = 0; ks < 4; ++ks) {
            const s16x4 a_lo = vtr(vb + ks * 1024), a_hi = vtr(vb + ks * 1024 + 512);
            const s16x4 b_lo = vtr(vb + 4096 + ks * 1024), b_hi = vtr(vb + 4096 + ks * 1024 + 512);
            const bf16x8 va = (bf16x8){a_lo[0], a_lo[1], a_lo[2], a_lo[3], a_hi[0], a_hi[1], a_hi[2], a_hi[3]};
            const bf16x8 vb2 = (bf16x8){b_lo[0], b_lo[1], b_lo[2], b_lo[3], b_hi[0], b_hi[1], b_hi[2], b_hi[3]};
            o0 = __builtin_amdgcn_mfma_f32_32x32x16_bf16(va, pf[ks], o0, 0, 0, 0);
            o1 = __builtin_amdgcn_mfma_f32_32x32x16_bf16(vb2, pf[ks], o1, 0, 0, 0);
        }
    }
    { auto rr = __builtin_amdgcn_permlane32_swap(__float_as_uint(l_run), __float_as_uint(l_run), false, false); l_run = __uint_as_float(rr[0]) + __uint_as_float(rr[1]); }
    const float inv = 1.0f / l_run;
    bf16* op = a.O + (long)qs * a.ostr + 4 * hi;
#pragma unroll
    for (int i = 0; i < 4; ++i) {
        v2u w0, w1; w0.x = cvt_pk_bf16(o0[4 * i] * inv, o0[4 * i + 1] * inv); w0.y = cvt_pk_bf16(o0[4 * i + 2] * inv, o0[4 * i + 3] * inv);
        w1.x = cvt_pk_bf16(o1[4 * i] * inv, o1[4 * i + 1] * inv); w1.y = cvt_pk_bf16(o1[4 * i + 2] * inv, o1[4 * i + 3] * inv);
        *(v2u*)(op + 8 * i) = w0; *(v2u*)(op + 32 + 8 * i) = w1;
    }
    if (a.LSE && hi == 0) a.LSE[(long)qs * a.lstr] = m_run + __builtin_amdgcn_logf(l_run);
}
}
__device__ __forceinline__ void transpose_item(const float* W, int ldw, int k0, int n0, bf16* WT, int ldt, int dst_row0, const float* kscale, LAS float* scr, int lane) {
#pragma unroll 8
    for (int i = 0; i < 32; ++i) { const int kk = 2 * i + (lane >> 5); float v = W[(size_t)(k0 + kk) * ldw + n0 + (lane & 31)]; if (kscale) v *= kscale[k0 + kk]; scr[kk * 33 + (lane & 31)] = v; }
    LDS_WAIT(); asm volatile("" ::: "memory");
    const int c = lane & 7;
#pragma unroll
    for (int j = 0; j < 4; ++j) { const int n = (lane >> 3) + 8 * j; const LAS float* s = scr + (8 * c) * 33 + n;
        v4u o; o.x = pk2(s[0 * 33], s[1 * 33]); o.y = pk2(s[2 * 33], s[3 * 33]); o.z = pk2(s[4 * 33], s[5 * 33]); o.w = pk2(s[6 * 33], s[7 * 33]);
        *(GAS v4u*)(WT + (size_t)(dst_row0 + n) * ldt + k0 + 8 * c) = o; }
    LDS_WAIT(); asm volatile("" ::: "memory");
}

__device__ __forceinline__ int t5_bucket(int dist) {
    if (dist < 16) return dist;
    const float v = logf((float)dist / 16.0f) / 4.852030263919617f * 16.0f;
    const int large = 16 + (int)v;
    return large < 31 ? large : 31;
}

struct RouterOut { int e0, e1; float w0, w1; };
__device__ __forceinline__ RouterOut route_row(const f32x4 (&v)[4], const float* wrg, const float* brg, const float* wre, const float* bre, int lane) {
    float g[4] = {0.f, 0.f, 0.f, 0.f};
#pragma unroll
    for (int j = 0; j < 4; ++j)
#pragma unroll
        for (int i = 0; i < 4; ++i) { const f32x4 w = *(const GAS f32x4*)(wrg + (size_t)(256 * j + 4 * lane + i) * 4); const float x = v[j][i];
            g[0] += x * w[0]; g[1] += x * w[1]; g[2] += x * w[2]; g[3] += x * w[3]; }
#pragma unroll
    for (int k = 0; k < 4; ++k) g[k] = wave_sum(g[k]) + brg[k];
    int grp = 0; float gm = g[0];
#pragma unroll
    for (int k = 1; k < 4; ++k) if (g[k] > gm) { gm = g[k]; grp = k; }
    float gs = 0.f;
#pragma unroll
    for (int k = 0; k < 4; ++k) gs += expf(g[k] - gm);
    const float pgrp = 1.0f / gs;
    float e[8] = {0.f, 0.f, 0.f, 0.f, 0.f, 0.f, 0.f, 0.f};
    const float* we = wre + (size_t)grp * D * 8;
#pragma unroll
    for (int j = 0; j < 4; ++j)
#pragma unroll
        for (int i = 0; i < 4; ++i) { const GAS f32x4* wp = (const GAS f32x4*)(we + (size_t)(256 * j + 4 * lane + i) * 8); const f32x4 wa = wp[0], wb = wp[1]; const float x = v[j][i];
            e[0] += x * wa[0]; e[1] += x * wa[1]; e[2] += x * wa[2]; e[3] += x * wa[3]; e[4] += x * wb[0]; e[5] += x * wb[1]; e[6] += x * wb[2]; e[7] += x * wb[3]; }
#pragma unroll
    for (int k = 0; k < 8; ++k) e[k] = wave_sum(e[k]) + bre[grp * 8 + k];
    int i0 = 0; float v0 = e[0];
#pragma unroll
    for (int k = 1; k < 8; ++k) if (e[k] > v0) { v0 = e[k]; i0 = k; }
    int i1 = -1; float v1 = -INFINITY;
#pragma unroll
    for (int k = 0; k < 8; ++k) if (k != i0 && e[k] > v1) { v1 = e[k]; i1 = k; }
    const float t = expf(v1 - v0);
    RouterOut r; r.e0 = grp * 8 + i0; r.e1 = grp * 8 + i1; r.w0 = pgrp / (1.0f + t); r.w1 = pgrp * t / (1.0f + t);
    return r;
}
constexpr size_t MiB = 1u << 20;
constexpr size_t WS_CTL = 0, CTL_ZERO_BYTES = 1 * MiB;
constexpr size_t WS_WIN = 2 * MiB;
constexpr size_t WS_WOUT = 28 * MiB;
constexpr size_t WS_WUQ = 36 * MiB;
constexpr size_t WS_WUKV = 38 * MiB;
constexpr size_t WS_COS = 40 * MiB, WS_SIN = 41 * MiB, WS_BT = 42 * MiB;
constexpr size_t WS_WGU = 44 * MiB;
constexpr size_t WS_WD = 76 * MiB;
constexpr size_t WS_XA = 92 * MiB;
constexpr size_t WS_X1 = 156 * MiB;
constexpr size_t WS_XB = 220 * MiB;
constexpr size_t WS_H = 252 * MiB;
constexpr size_t WS_Z = WS_H;
constexpr size_t WS_HM = WS_H + 64 * MiB;
constexpr size_t WS_QC = 356 * MiB, WS_KC = 380 * MiB, WS_VC = 404 * MiB;
constexpr size_t WS_YS = WS_QC;
constexpr size_t WS_OBG = 420 * MiB, WS_LSE = 444 * MiB;
constexpr size_t WS_OCAT = 446 * MiB;
constexpr size_t WS_LTOK = 478 * MiB, WS_LW = 480 * MiB, WS_LDST = 482 * MiB;
constexpr size_t WS_TOKE = 484 * MiB, WS_TOKW = WS_TOKE + 512 * 1024;
constexpr size_t WS_SSQ = 485 * MiB;
constexpr size_t WS_END = 486 * MiB;
constexpr int CW_DBG = 8;
constexpr int CW_BAR = 4096;
constexpr int CW_CNT = 16384;
constexpr int RING_OFF = 0, RING_BYTES = 131072;
constexpr int LDSCTL_OFF = RING_BYTES;
constexpr int LDS_BYTES = 147456;
constexpr int NWAVES = 8;
constexpr int NPH = 8, NPHASES = 1 + DEPTH * NPH;

struct Args { const float* in[20]; float* out; unsigned char* ws; int ph_lo, ph_hi; };

#define FRESH() \
    unsigned char* ws = args.ws; asm volatile("" : "+s"(ws)); \
    int tid = threadIdx.x; asm volatile("" : "+v"(tid)); \
    const int lane = tid & 63, wave = __builtin_amdgcn_readfirstlane(tid >> 6); \
    const int gw = vcu * NWAVES + wave, NGW = G * NWAVES; \
    gu32* const ctl = (gu32*)(ws + WS_CTL); \
    bf16* const WIN = (bf16*)(ws + WS_WIN); bf16* const WOUT = (bf16*)(ws + WS_WOUT); bf16* const WUQ = (bf16*)(ws + WS_WUQ); bf16* const WUKV = (bf16*)(ws + WS_WUKV); \
    float* const COS = (float*)(ws + WS_COS); float* const SIN = (float*)(ws + WS_SIN); float* const BT = (float*)(ws + WS_BT); \
    bf16* const WGU = (bf16*)(ws + WS_WGU); bf16* const WD = (bf16*)(ws + WS_WD); \
    float* const XA = (float*)(ws + WS_XA); float* const X1 = (float*)(ws + WS_X1); bf16* const XB = (bf16*)(ws + WS_XB); \
    bf16* const H = (bf16*)(ws + WS_H); float* const Z = (float*)(ws + WS_Z); bf16* const HM = (bf16*)(ws + WS_HM); \
    bf16* const QC = (bf16*)(ws + WS_QC); bf16* const KC = (bf16*)(ws + WS_KC); bf16* const VC = (bf16*)(ws + WS_VC); bf16* const YS = (bf16*)(ws + WS_YS); \
    bf16* const OBG = (bf16*)(ws + WS_OBG); float* const LSE = (float*)(ws + WS_LSE); bf16* const OCAT = (bf16*)(ws + WS_OCAT); \
    int* const LTOK = (int*)(ws + WS_LTOK); float* const LW = (float*)(ws + WS_LW); int* const LDST = (int*)(ws + WS_LDST); \
    int* const TOKE = (int*)(ws + WS_TOKE); float* const TOKW = (float*)(ws + WS_TOKW); \
    float* const SSQ = (float*)(ws + WS_SSQ); \
    LAS float* const scr = (LAS float*)(lds + RING_OFF + wave * 16384); \
    (void)lane; (void)gw; (void)NGW; (void)ctl; (void)WIN; (void)WOUT; (void)WUQ; (void)WUKV; (void)COS; (void)SIN; (void)BT; (void)WGU; (void)WD; (void)XA; (void)X1; (void)XB; (void)H; (void)Z; (void)HM; (void)QC; (void)KC; (void)VC; (void)YS; (void)OBG; (void)LSE; (void)OCAT; (void)LTOK; (void)LW; (void)LDST; (void)TOKE; (void)TOKW; (void)SSQ; (void)scr;

__global__ void __launch_bounds__(NWAVES * 64, 2) mega_fwd(Args args) {
    extern __shared__ __attribute__((aligned(16))) unsigned char lds_raw[];
    LAS unsigned char* lds = (LAS unsigned char*)lds_raw;
    const int tid0 = threadIdx.x;
    const int G = gridDim.x; const int bx = blockIdx.x; const int vcu = (G % 8 == 0) ? (bx % 8) * (G / 8) + bx / 8 : bx;
    gu32* const ctl0 = (gu32*)(args.ws + WS_CTL);
    volatile LAS unsigned* LCTL = (volatile LAS unsigned*)(lds + LDSCTL_OFF);
    volatile LAS int* tstart = (volatile LAS int*)(lds + LDSCTL_OFF + 64);
    volatile LAS int* cnts = (volatile LAS int*)(lds + LDSCTL_OFF + 256);
    for (int u = tid0; u < (LDS_BYTES - LDSCTL_OFF) / 4; u += NWAVES * 64) LCTL[u] = 0u;
    __syncthreads();
    const int lo = args.ph_lo, hi = args.ph_hi;
    XcdBarrier bar; bar.bar = (unsigned*)(ctl0 + CW_BAR); bar.x = 0; bar.st = nullptr;
    if (hi - lo > 1) bar = xcd_barrier_post((unsigned*)(ctl0 + CW_BAR), LCTL);
#ifndef PH_MASK
#define PH_MASK 0x1ff
#endif
#define PHON(p) (((PH_MASK) >> (p)) & 1)
#define IN(k) (lo <= (k) && (k) < hi)
#define SEAM(k) do { if (IN(k) && IN((k) + 1)) xcd_barrier(bar); } while (0)

    if (PHON(0) && IN(0)) {
        FRESH();
        constexpr int I_WIN = 16 * 101, I_WOUT = 16 * 32, I_WUQ = 4 * 24, I_WUKV = 2 * 32, I_L = I_WIN + I_WOUT + I_WUQ + I_WUKV;
        for (int it = gw; it < DEPTH * I_L; it += NGW) {
            const int l = it / I_L; int r = it % I_L;
            if (r < I_WIN) { transpose_item(args.in[1] + (size_t)l * D * NIN, NIN, 64 * (r / 101), 32 * (r % 101), WIN + (size_t)l * NINP * D, D, 32 * (r % 101), nullptr, scr, lane); continue; } r -= I_WIN;
            if (r < I_WOUT) { transpose_item(args.in[2] + (size_t)l * D * D, D, 64 * (r / 32), 32 * (r % 32), WOUT + (size_t)l * D * D, D, 32 * (r % 32), nullptr, scr, lane); continue; } r -= I_WOUT;
            if (r < I_WUQ) { transpose_item(args.in[7] + (size_t)l * 256 * 768, 768, 64 * (r / 24), 32 * (r % 24), WUQ + (size_t)l * 768 * 256, 256, 32 * (r % 24), args.in[5] + l * 256, scr, lane); continue; } r -= I_WUQ;
            transpose_item(args.in[8] + (size_t)l * 128 * 1024, 1024, 64 * (r / 32), 32 * (r % 32), WUKV + (size_t)l * 1024 * 128, 128, 32 * (r % 32), args.in[6] + l * 128, scr, lane);
        }
        for (int it = gw; it < DEPTH * 96; it += NGW) {
            GAS v4u* p = (GAS v4u*)(WIN + ((size_t)(it / 96) * NINP + NIN + it % 96) * D);
            p[lane] = (v4u){0u, 0u, 0u, 0u}; p[lane + 64] = (v4u){0u, 0u, 0u, 0u};
        }
        for (int i = gw * 64 + lane; i < T * 16; i += NGW * 64) {
            const int t = i >> 4, j = i & 15;
            const float inv_freq = powf(10000.0f, -(float)(2 * j) / 32.0f);
            const float ang = (float)t * inv_freq;
            COS[i] = cosf(ang); SIN[i] = sinf(ang);
        }
        for (int i = gw * 64 + lane; i < 16 * 132; i += NGW * 64) {
            const int h = i / 132, d = i % 132; const int dil = h < 8 ? 1 : (h < 12 ? 4 : 16);
            BT[i] = args.in[4][t5_bucket(d * dil) * 16 + h] * LOG2E;
        }
        for (int m = gw; m < T; m += NGW) {
            const GAS f32x4* xr = (const GAS f32x4*)(args.in[0] + (size_t)m * D) + lane; GAS v2u* o = (GAS v2u*)(XB + (size_t)m * D) + lane;
#pragma unroll
            for (int j = 0; j < 4; ++j) { const f32x4 v = xr[64 * j]; o[64 * j] = (v2u){pk2(v[0], v[1]), pk2(v[2], v[3])}; }
        }
    }
    SEAM(0);

    for (int layer = 0; layer < DEPTH; ++layer) {
        const int pb = 1 + layer * NPH;
        if (hi <= pb || lo >= pb + NPH) continue;

        if (PHON(1) && IN(pb + 0)) {
            FRESH();
            pg8::Gemm g{XB, WIN + (size_t)layer * NINP * D, D, D, D}; pg8::StaticOrder S; S.init(T, NINP, G, bx);
            pg8::EpiGemm1 E{H, KC, SSQ, COS, SIN};
            pg8::gemm_phase<pg8::EpiGemm1, pg8::StaticOrder, true>(lds + RING_OFF, g, S, E);
        }
        SEAM(pb + 0);

        if (PHON(2) && IN(pb + 1)) {
            FRESH();
#ifndef P2SUB
#define P2SUB 7
#endif
            if (P2SUB & 1) { pg8::Gemm g{H + C_Q, WUQ + (size_t)layer * 768 * 256, NINP, 256, 256}; pg8::StaticOrder S; S.init(T, 768, G, bx);
              pg8::EpiUpQ E{QC, SSQ, COS, SIN};
              pg8::gemm_phase<pg8::EpiUpQ, pg8::StaticOrder, true>(lds + RING_OFF, g, S, E); }
            if (P2SUB & 2) { pg8::Gemm g{H + C_KV, WUKV + (size_t)layer * 1024 * 128, NINP, 128, 128}; pg8::StaticOrder S; S.init(T, 1024, G, bx);
              pg8::EpiUpKV E{KC, VC, SSQ};
              pg8::gemm_phase<pg8::EpiUpKV, pg8::StaticOrder, true>(lds + RING_OFF, g, S, E); }
            if (P2SUB & 4) for (int u = vcu; u < 1024; u += G) {
                const int h16 = u >> 6, blk = u & 63;
                att::AttnP a;
                int dil = 1, r = 0, q0 = blk * 256;
                if (h16 < 4) {
                    a.Q = H + A_Q + h16 * 64; a.K = H + A_K + (h16 >> 1) * 64; a.V = H + A_V + (h16 >> 1) * 64;
                    a.O = OCAT + h16 * 64; a.ostr = 1024; a.LSE = nullptr; a.lstr = 0; a.W = 127;
                    a.m_init = args.in[3][layer * 4 + h16] * LOG2E; a.l_init = 1.0f;
                } else {
                    const int hb = h16 - 4, g = hb >> 2; dil = g == 0 ? 1 : (g == 1 ? 4 : 16);
                    const int nblk = (T / dil) / 256; r = blk / nblk; q0 = (blk % nblk) * 256;
                    a.Q = H + (size_t)r * NINP + B_Q + hb * 64; a.K = H + (size_t)r * NINP + B_K + hb * 64; a.V = H + (size_t)r * NINP + B_V + hb * 64;
                    a.O = OBG + (size_t)r * 768 + hb * 64; a.ostr = (long)dil * 768; a.LSE = LSE + (size_t)r * 12 + hb; a.lstr = (long)dil * 12; a.W = 128;
                    a.m_init = -INFINITY; a.l_init = 0.f;
                }
                a.qstr = a.kstr = a.vstr = (long)dil * NINP; a.q0 = q0; a.k0 = q0 - 128; a.nt = 6;
                __syncthreads();
                if (tid < 132) ((LAS float*)(lds + RING_OFF + att::Lay<64>::BOFF))[tid] = BT[h16 * 132 + tid];
                att::attn_unit<64, 0>(a, lds + RING_OFF);
            }
        }
        SEAM(pb + 1);

        if (PHON(3) && IN(pb + 2)) {
            FRESH();
            for (int t = gw; t < T; t += NGW) {
                const int hh = lane >> 4, d4 = (lane & 15) * 4;
                float l3[3], w3[3];
#pragma unroll
                for (int g = 0; g < 3; ++g) l3[g] = LSE[(size_t)t * 12 + g * 4 + hh];
                const float mx = fmaxf(fmaxf(l3[0], l3[1]), l3[2]);
                float s = 0.f;
#pragma unroll
                for (int g = 0; g < 3; ++g) { w3[g] = __builtin_amdgcn_exp2f(l3[g] - mx); s += w3[g]; }
                const float inv = 1.0f / s; float o[4] = {0.f, 0.f, 0.f, 0.f};
#pragma unroll
                for (int g = 0; g < 3; ++g) { const v2u w = *(const GAS v2u*)(OBG + (size_t)t * 768 + (g * 4 + hh) * 64 + d4); const float wg = w3[g] * inv;
                    o[0] += wg * bf2f((bf16)(w.x & 0xffffu)); o[1] += wg * bf2f((bf16)(w.x >> 16)); o[2] += wg * bf2f((bf16)(w.y & 0xffffu)); o[3] += wg * bf2f((bf16)(w.y >> 16)); }
                *(GAS v2u*)(OCAT + (size_t)t * 1024 + 256 + hh * 64 + d4) = (v2u){pk2(o[0], o[1]), pk2(o[2], o[3])};
            }
            for (int p = vcu; p < 256; p += G) {
                const int head = p >> 5, s = p & 31;
#pragma unroll 1
                for (int k = 0; k < 2; ++k) {
                    const int qb = k == 0 ? s : 63 - s;
                    att::AttnP a;
                    a.Q = QC + head * 96; a.qstr = 768; a.K = KC + head * 96; a.kstr = 768; a.V = VC + head * 64; a.vstr = 512;
                    a.O = OCAT + 512 + head * 64; a.ostr = 1024; a.LSE = nullptr; a.lstr = 0; a.W = 0;
                    a.q0 = qb * 256; a.k0 = 0; a.nt = (a.q0 + 256) / 64; a.m_init = -INFINITY; a.l_init = 0.f;
                    att::attn_unit<96, 2>(a, lds + RING_OFF);
                }
            }
        }
        SEAM(pb + 2);

        if (PHON(4) && IN(pb + 3)) {
            FRESH();
            pg8::Gemm g{OCAT, WOUT + (size_t)layer * D * D, D, D, D}; pg8::StaticOrder S; S.init(T, D, G, bx);
            const float* Xin = layer == 0 ? args.in[0] : XA;
            pg8::EpiOut E{Xin, Z};
            pg8::gemm_phase<pg8::EpiOut, pg8::StaticOrder, true>(lds + RING_OFF, g, S, E);
        }
        SEAM(pb + 3);

        if (PHON(5) && IN(pb + 4)) {
            FRESH();
            const float* wg = args.in[15] + (size_t)layer * NEXP * D * DEXP; const float* wu = args.in[16] + (size_t)layer * NEXP * D * DEXP; const float* wd = args.in[17] + (size_t)layer * NEXP * DEXP * D;
            for (int it = gw; it < 3 * 4096; it += NGW) {
                const int which = it >> 12, r = it & 4095, e = r >> 7, q = r & 127;
                if (which < 2) { const int kb = q >> 3, nb = q & 7;
                    transpose_item((which == 0 ? wg : wu) + (size_t)e * D * DEXP, DEXP, 64 * kb, 32 * nb, WGU + (size_t)e * 512 * D, D, (nb >> 2) * 256 + which * 128 + (nb & 3) * 32, nullptr, scr, lane);
                } else { const int kb = q >> 5, nb = q & 31;
                    transpose_item(wd + (size_t)e * DEXP * D, D, 64 * kb, 32 * nb, WD + (size_t)e * D * DEXP, DEXP, 32 * nb, nullptr, scr, lane); }
            }
            __syncthreads();
            LAS int* row_e = (LAS int*)(lds + RING_OFF); LAS float* row_w = (LAS float*)(lds + RING_OFF + 512); LAS int* row_p = (LAS int*)(lds + RING_OFF + 1024);
            LAS int* lcnt = (LAS int*)(lds + RING_OFF + 1536); LAS int* lbase = (LAS int*)(lds + RING_OFF + 1664);
            const float* g1 = args.in[9] + layer * D; const float* b1 = args.in[10] + layer * D;
            f32x4 gv[4], bv[4];
#pragma unroll
            for (int j = 0; j < 4; ++j) { gv[j] = *(const GAS f32x4*)(g1 + 256 * j + 4 * lane); bv[j] = *(const GAS f32x4*)(b1 + 256 * j + 4 * lane); }
            for (int rb = vcu; rb < T / 64; rb += G) {
                if (tid < 32) lcnt[tid] = 0;
                __syncthreads();
                for (int i = 0; i < 8; ++i) {
                    const int rl = wave * 8 + i, row = rb * 64 + rl;
                    const GAS f32x4* zr = (const GAS f32x4*)(Z + (size_t)row * D) + lane;
                    f32x4 v[4]; float s = 0.f;
#pragma unroll
                    for (int j = 0; j < 4; ++j) { v[j] = zr[64 * j]; s += (v[j][0] + v[j][1]) + (v[j][2] + v[j][3]); }
                    const float mean = wave_sum(s) * (1.f / D); float s2 = 0.f;
#pragma unroll
                    for (int j = 0; j < 4; ++j) { v[j] = v[j] - mean; s2 += (v[j][0] * v[j][0] + v[j][1] * v[j][1]) + (v[j][2] * v[j][2] + v[j][3] * v[j][3]); }
                    const float rstd = 1.f / sqrtf(wave_sum(s2) * (1.f / D) + 1e-5f);
                    GAS f32x4* xo = (GAS f32x4*)(X1 + (size_t)row * D) + lane; GAS v2u* xb = (GAS v2u*)(XB + (size_t)row * D) + lane;
#pragma unroll
                    for (int j = 0; j < 4; ++j) { v[j] = v[j] * rstd * gv[j] + bv[j]; xo[64 * j] = v[j]; xb[64 * j] = (v2u){pk2(v[j][0], v[j][1]), pk2(v[j][2], v[j][3])}; }
                    const RouterOut ro = route_row(v, args.in[11] + (size_t)layer * D * 4, args.in[12] + layer * 4, args.in[13] + (size_t)layer * 4 * D * 8, args.in[14] + layer * 32, lane);
                    if (lane == 0) {
                        row_e[rl * 2] = ro.e0; row_e[rl * 2 + 1] = ro.e1; row_w[rl * 2] = ro.w0; row_w[rl * 2 + 1] = ro.w1;
                        row_p[rl * 2] = __hip_atomic_fetch_add(&lcnt[ro.e0], 1, __ATOMIC_RELAXED, __HIP_MEMORY_SCOPE_WORKGROUP);
                        row_p[rl * 2 + 1] = __hip_atomic_fetch_add(&lcnt[ro.e1], 1, __ATOMIC_RELAXED, __HIP_MEMORY_SCOPE_WORKGROUP);
                    }
                }
                __syncthreads();
                if (tid < 32) lbase[tid] = (int)__hip_atomic_fetch_add(ctl + CW_CNT + layer * 32 + tid, (unsigned)lcnt[tid], RLX_AGENT);
                __syncthreads();
                if (tid < 128) { const int rl = tid >> 1, k = tid & 1, row = rb * 64 + rl; const int e = row_e[tid]; const int idx = lbase[e] + row_p[tid]; const float w = row_w[tid];
                    LTOK[(size_t)e * T + idx] = row; LW[(size_t)e * T + idx] = w; LDST[(size_t)e * T + idx] = 2 * row + k; TOKE[2 * row + k] = e; TOKW[2 * row + k] = w; }
                __syncthreads();
            }
        }
        SEAM(pb + 4);

        if ((PHON(6) || PHON(7)) && (IN(pb + 5) || IN(pb + 6))) {
            FRESH();
            if (tid < 32) cnts[tid] = (int)__hip_atomic_load(ctl + CW_CNT + layer * 32 + tid, RLX_AGENT);
            __syncthreads();
            if (tid == 0) { int acc = 0; for (int e = 0; e < 32; ++e) { tstart[e] = acc; acc += (cnts[e] + 255) >> 8; } tstart[32] = acc; }
            __syncthreads();
        }
        if (PHON(6) && IN(pb + 5)) {
            FRESH();
            pg8::MoeOrder S; S.tstart = tstart; S.cnts = cnts; S.list_tok = LTOK; S.npn = 2; S.G = G; S.c = vcu;
            pg8::Gemm g{XB, WGU, D, D, D}; pg8::EpiMoe1 E{HM};
            pg8::gemm_phase<pg8::EpiMoe1, pg8::MoeOrder, true>(lds + RING_OFF, g, S, E);
        }
        SEAM(pb + 5);
        if (PHON(7) && IN(pb + 6)) {
            FRESH();
            pg8::MoeOrderDense S; S.tstart = tstart; S.cnts = cnts; S.list_tok = LTOK; S.npn = 4; S.G = G; S.c = vcu;
            pg8::Gemm g{HM, WD, DEXP, DEXP, DEXP}; pg8::EpiMoe2 E{YS, LDST, LW, cnts};
            pg8::gemm_phase<pg8::EpiMoe2, pg8::MoeOrderDense, true>(lds + RING_OFF, g, S, E);
        }
        SEAM(pb + 6);

        if (PHON(8) && IN(pb + 7)) {
            FRESH();
            float* Xout = layer == DEPTH - 1 ? args.out : XA;
            const float* g2 = args.in[18] + layer * D; const float* b2 = args.in[19] + layer * D;
            f32x4 gv[4], bv[4];
#pragma unroll
            for (int j = 0; j < 4; ++j) { gv[j] = *(const GAS f32x4*)(g2 + 256 * j + 4 * lane); bv[j] = *(const GAS f32x4*)(b2 + 256 * j + 4 * lane); }
            for (int row = gw; row < T; row += NGW) {
                const GAS f32x4* xr = (const GAS f32x4*)(X1 + (size_t)row * D) + lane;
                const GAS v2u* y0 = (const GAS v2u*)(YS + (size_t)(2 * row) * D) + lane; const GAS v2u* y1 = (const GAS v2u*)(YS + (size_t)(2 * row + 1) * D) + lane;
                f32x4 v[4]; float s = 0.f;
#pragma unroll
                for (int j = 0; j < 4; ++j) { const f32x4 x = xr[64 * j]; const v2u a = y0[64 * j], b = y1[64 * j];
                    v[j][0] = x[0] * ALPHA + (bf2f((bf16)(a.x & 0xffffu)) + bf2f((bf16)(b.x & 0xffffu))); v[j][1] = x[1] * ALPHA + (bf2f((bf16)(a.x >> 16)) + bf2f((bf16)(b.x >> 16)));
                    v[j][2] = x[2] * ALPHA + (bf2f((bf16)(a.y & 0xffffu)) + bf2f((bf16)(b.y & 0xffffu))); v[j][3] = x[3] * ALPHA + (bf2f((bf16)(a.y >> 16)) + bf2f((bf16)(b.y >> 16)));
                    s += (v[j][0] + v[j][1]) + (v[j][2] + v[j][3]); }
                const float mean = wave_sum(s) * (1.f / D); float s2 = 0.f;
#pragma unroll
                for (int j = 0; j < 4; ++j) { v[j] = v[j] - mean; s2 += (v[j][0] * v[j][0] + v[j][1] * v[j][1]) + (v[j][2] * v[j][2] + v[j][3] * v[j][3]); }
                const float rstd = 1.f / sqrtf(wave_sum(s2) * (1.f / D) + 1e-5f);
                GAS f32x4* xo = (GAS f32x4*)(Xout + (size_t)row * D) + lane; GAS v2u* xb = (GAS v2u*)(XB + (size_t)row * D) + lane;
#pragma unroll
                for (int j = 0; j < 4; ++j) { v[j] = v[j] * rstd * gv[j] + bv[j]; xo[64 * j] = v[j]; xb[64 * j] = (v2u){pk2(v[j][0], v[j][1]), pk2(v[j][2], v[j][3])}; }
            }
        }
        SEAM(pb + 7);
    }
#undef IN
#undef SEAM
}
#define DBG_AFTER_PHASE(ph) do {} while (0)
#define DBG_FINISH() do {} while (0)
#ifndef MK_MULTI
#define MK_MULTI 0
#endif
extern "C" void kernel_launch(void* const* d_in, const int* in_sizes, int n_in, void* d_out, int out_size, void* d_ws, size_t ws_size, hipStream_t stream) {
    static int grid = 0;
    if (grid == 0) {
        if (n_in != 20 || in_sizes[0] != T * D || out_size != T * D || ws_size < WS_END) { fprintf(stderr, "kernel_launch: unexpected problem shape / workspace (%d inputs, ws %zu)\n", n_in, ws_size); grid = -1; return; }
        int dev = 0, cus = 0, per_cu = 0;
        if (hipGetDevice(&dev) != hipSuccess || hipDeviceGetAttribute(&cus, hipDeviceAttributeMultiprocessorCount, dev) != hipSuccess) { grid = -1; return; }
        if (hipFuncSetAttribute((const void*)mega_fwd, hipFuncAttributeMaxDynamicSharedMemorySize, LDS_BYTES) != hipSuccess) { fprintf(stderr, "kernel_launch: hipFuncSetAttribute failed\n"); grid = -1; return; }
        if (hipOccupancyMaxActiveBlocksPerMultiprocessor(&per_cu, (const void*)mega_fwd, NWAVES * 64, LDS_BYTES) != hipSuccess || per_cu < 1) { fprintf(stderr, "kernel_launch: occupancy query says %d\n", per_cu); }
        (void)hipGetLastError();
        grid = cus;
    }
    if (grid < 0) return;
    (void)hipMemsetAsync((char*)d_ws + WS_CTL, 0, CTL_ZERO_BYTES, stream);
    Args a{};
    for (int i = 0; i < 20; ++i) a.in[i] = (const float*)d_in[i];
    a.out = (float*)d_out; a.ws = (unsigned char*)d_ws;
#if MK_MULTI
    for (int ph = 0; ph < NPHASES; ++ph) {
        a.ph_lo = ph; a.ph_hi = ph + 1;
        hipLaunchKernelGGL(mega_fwd, dim3(grid), dim3(NWAVES * 64), LDS_BYTES, stream, a);
        DBG_AFTER_PHASE(ph);
    }
    DBG_FINISH();
#else
    a.ph_lo = 0; a.ph_hi = NPHASES;
    hipLaunchKernelGGL(mega_fwd, dim3(grid), dim3(NWAVES * 64), LDS_BYTES, stream, a);
#endif
}
```

```cpp
#include <hip/hip_runtime.h>
#include <cstdio>
#include <cstdint>

#define GAS __attribute__((address_space(1)))
#define LAS __attribute__((address_space(3)))
typedef unsigned short bf16;
typedef unsigned v4u __attribute__((ext_vector_type(4)));
typedef unsigned v2u __attribute__((ext_vector_type(2)));
typedef float f32x4 __attribute__((ext_vector_type(4)));
typedef float f32x2 __attribute__((ext_vector_type(2)));
typedef float f32x16 __attribute__((ext_vector_type(16)));
typedef short bf16x8 __attribute__((ext_vector_type(8)));
typedef short s16x4 __attribute__((ext_vector_type(4)));
typedef GAS unsigned gu32;
#define RLX_AGENT __ATOMIC_RELAXED, __HIP_MEMORY_SCOPE_AGENT
#define LDS_WAIT() asm volatile("s_waitcnt lgkmcnt(0)" ::: "memory")
#define VM_WAIT() asm volatile("s_waitcnt vmcnt(0)" ::: "memory")

constexpr int T = 16384, D = 1024, DEPTH = 4;
constexpr int NIN = 3232, NINP = 3328;
constexpr int HD = 64;
constexpr int A_Q = 0, A_K = 256, A_V = 384;
constexpr int B_Q = 512, B_K = 512 + 768, B_V = 512 + 1536;
constexpr int C_Q = 2816, C_KV = 3072, C_ROPE = 3200;
constexpr int NEXP = 32, DEXP = 256;
constexpr float ALPHA = 1.681792830507429f;
constexpr float LOG2E = 1.4426950408889634f;
constexpr float C_AB = 0.125f * LOG2E;
constexpr float C_MLA = 0.10206207261596577f * LOG2E;

__device__ __forceinline__ unsigned f2bf(float f) { unsigned u = __builtin_bit_cast(unsigned, f); return (u + 0x7fffu + ((u >> 16) & 1u)) >> 16; }
__device__ __forceinline__ unsigned pk2(float lo, float hi) { return f2bf(lo) | (f2bf(hi) << 16); }
__device__ __forceinline__ float bf2f(bf16 b) { return __builtin_bit_cast(float, (unsigned)b << 16); }
__device__ __forceinline__ unsigned cvt_pk_bf16(float lo, float hi) { unsigned r; asm volatile("v_cvt_pk_bf16_f32 %0, %1, %2" : "=v"(r) : "v"(lo), "v"(hi)); return r; }
__device__ __forceinline__ float wave_sum(float v) {
#pragma unroll
    for (int o = 1; o < 64; o <<= 1) v += __shfl_xor(v, o);
    return v;
}

#define XB_TMO      128
#define XB_XCNT(j)  (256  + 64 * (j))
#define XB_XSUB(j)  (1280 + 64 * (j))
#define XB_XGEN(j)  (2304 + 64 * (j))
#define XB_TOP      3328
#define XB_TOPGEN   3392
#define XCD_BAR_WORDS 3456
#define XB_SPIN_CAP (1u << 18)

__device__ __forceinline__ unsigned xb_ld(unsigned* p)              { return __hip_atomic_load(p, __ATOMIC_RELAXED, __HIP_MEMORY_SCOPE_AGENT); }
__device__ __forceinline__ unsigned xb_add(unsigned* p, unsigned v) { return __hip_atomic_fetch_add(p, v, __ATOMIC_RELAXED, __HIP_MEMORY_SCOPE_AGENT); }
__device__ __forceinline__ unsigned xb_xcc_id() { return (unsigned)__builtin_amdgcn_s_getreg((3 << 11) | 20) & 0xFu; }
#define XB_SPIN(cond, bar) do { unsigned _sp = 0; while (cond) { __builtin_amdgcn_s_sleep(1); \
    if ((++_sp & 255u) == 0u) { if (xb_ld(&(bar)[XB_TMO])) break; if (_sp > XB_SPIN_CAP) { atomicAdd(&(bar)[XB_TMO], 1u); break; } } } } while (0)

struct XcdBarrier {
    unsigned* bar; unsigned x;
    volatile LAS unsigned* st;
};
__device__ __forceinline__ XcdBarrier xcd_barrier_post(unsigned* bar, volatile LAS unsigned* st) {
    XcdBarrier b; b.bar = bar; b.x = xb_xcc_id(); b.st = st;
    if (threadIdx.x == 0) (void)xb_add(&bar[XB_XCNT(b.x)], 1u);
    return b;
}
__device__ __forceinline__ void xcd_barrier_complete(unsigned* bar, unsigned x, unsigned& nloc, unsigned& nx) {
    const unsigned G = gridDim.x * gridDim.y * gridDim.z;
    unsigned sum, cnt, mine, sp = 0u;
    for (;;) {
        sum = 0u; cnt = 0u; mine = 0u;
#pragma unroll
        for (unsigned j = 0; j < 16; ++j) { const unsigned c = xb_ld(&bar[XB_XCNT(j)]); sum += c; cnt += (c > 0u) ? 1u : 0u; mine = (j == x) ? c : mine; }
        if (sum == G) break;
        __builtin_amdgcn_s_sleep(1);
        if ((++sp & 255u) == 0u) { if (xb_ld(&bar[XB_TMO])) break; if (sp > XB_SPIN_CAP) { atomicAdd(&bar[XB_TMO], 1u); break; } }
    }
    nloc = mine > 0u ? mine : 1u; nx = cnt > 0u ? cnt : 1u;
}
__device__ __forceinline__ void xcd_barrier(const XcdBarrier& b) {
    asm volatile("s_waitcnt vmcnt(0)" ::: "memory");
    __syncthreads();
    if (threadIdx.x == 0) {
        unsigned* bar = b.bar;
        __builtin_amdgcn_s_waitcnt(0);
        unsigned nloc = b.st[0], nx = b.st[1];
        if (nloc == 0u) { xcd_barrier_complete(bar, b.x, nloc, nx); b.st[0] = nloc; b.st[1] = nx; }
        const unsigned old = xb_add(&bar[XB_XSUB(b.x)], 1u);
        const unsigned gen = old / nloc;
        if (old + 1u == (gen + 1u) * nloc) {
            __builtin_amdgcn_fence(__ATOMIC_RELEASE, "agent");
            asm volatile("s_waitcnt vmcnt(0)" ::: "memory");
            const unsigned og = xb_add(&bar[XB_TOP], 1u);
            const unsigned tg = og / nx;
            if (og + 1u == (tg + 1u) * nx) xb_add(&bar[XB_TOPGEN], 1u);
            else XB_SPIN(xb_ld(&bar[XB_TOPGEN]) == tg, bar);
            __builtin_amdgcn_fence(__ATOMIC_ACQUIRE, "agent");
            xb_add(&bar[XB_XGEN(b.x)], 1u);
            asm volatile("s_waitcnt vmcnt(0)" ::: "memory");
        } else {
            XB_SPIN(xb_ld(&bar[XB_XGEN(b.x)]) == gen, bar);
            __builtin_amdgcn_fence(__ATOMIC_ACQUIRE, "agent");
            asm volatile("s_waitcnt vmcnt(0)" ::: "memory");
        }
    }
    __syncthreads();
}
namespace pg8 {
constexpr int BM = 256, BK = 64, HALF = 128, HTB = HALF * BK * 2  , STAGE_BYTES = 8 * HTB, NXCD = 8, WGM = 8;

__host__ __device__ __forceinline__ int lds_byte(int r, int c) { const int st = (r >> 4) * 2 + (c >> 5), rr = r & 15, cc = c & 31, ob = rr * 64 + cc * 2; return st * 1024 + (ob ^ (((ob >> 9) & 1) << 5)); }
__host__ __device__ __forceinline__ void stage_rc(int b, int& R, int& C) { const int st = b / 1024, sb = b % 1024, swz = sb ^ (((sb >> 9) & 1) << 5); R = (st >> 1) * 16 + swz / 64; C = (st & 1) * 32 + (swz % 64) / 2; }
__host__ __device__ __forceinline__ int perm32(int rho) { const int n = rho >> 4, i = rho & 15; return 8 * (i >> 2) + 4 * n + (i & 3); }

struct Unit { int pm, pn, e, lrt; };
struct Gemm { const bf16* A; const bf16* Bt; int lda, ldb, K; };

struct StaticOrder {
    static constexpr bool GATHER = false;
    int nM, nN, nwg, G, c;
    __device__ void init(int M, int N, int G_, int c_) { nM = M / BM; nN = N / BM; nwg = nM * nN; G = G_; c = c_; }
    __device__ bool next(int i, Unit& u) const {
        const long L = (long)i * G + c; if (L >= nwg) return false;
        int wgid = (int)L; { const int q = nwg / NXCD, r = nwg % NXCD, xcd = wgid % NXCD, off = wgid / NXCD; wgid = (xcd < r ? xcd * (q + 1) : r * (q + 1) + (xcd - r) * q) + off; }
        const int nig = WGM * nN, gid = wgid / nig, fm = gid * WGM, gsz = (nM - fm) < WGM ? (nM - fm) : WGM;
        u.pm = fm + ((wgid % nig) % gsz); u.pn = (wgid % nig) / gsz; u.e = 0; u.lrt = 0; return true;
    }
    __device__ __forceinline__ int arow(const Unit&, int) const { return 0; }
};

template <class Epi, class Sched, bool ALIGN_EPI>
__device__ __forceinline__ void gemm_phase(LAS unsigned char* lds, const Gemm g, const Sched& S, const Epi& E) {
    int tid = threadIdx.x; asm volatile("" : "+v"(tid));
    const int wid = __builtin_amdgcn_readfirstlane(tid >> 6), lane = tid & 63, wr = wid >> 2, wc = wid & 3, fr = lane & 15, fq = lane >> 4;
    int K = g.K; asm volatile("" : "+s"(K));
    const int nt = K / BK;
    int RA[2], CA[2];
    unsigned voffB[2];
#pragma unroll
    for (int i = 0; i < 2; ++i) { int R, C; stage_rc(tid * 16 + i * 8192, R, C); const int Rb = Epi::PERM ? ((R & ~31) + perm32(R & 31)) : R;
        RA[i] = R; CA[i] = C; voffB[i] = (unsigned)(Rb * g.ldb + C) * 2u; }
    const size_t kstep = (size_t)(BK * 2);
    const size_t hstepB = (size_t)HALF * g.ldb * 2, tstepB = 2 * hstepB;
    const unsigned ldsw = (unsigned)wid * 1024u;
    const int aoff = lds_byte(wr * 64 + fr, fq * 8), boff = lds_byte(wc * 32 + fr, fq * 8);
#define PG8_SA(b, h) (((b) * 2 + (h)) * HTB)
#define PG8_SB(b, h) ((4 + (b) * 2 + (h)) * HTB)
#define PG8_STAGE(bufoff, gbase, voff) do { _Pragma("unroll") for (int _i = 0; _i < 2; ++_i) \
        __builtin_amdgcn_global_load_lds((const unsigned*)((const char*)(gbase) + (voff)[_i]), (LAS unsigned*)(lds + (bufoff) + ldsw + _i * 8192), 16, 0, 0); } while (0)
#define PG8_LDA(dst, b, h) do { _Pragma("unroll") for (int m = 0; m < 4; ++m) _Pragma("unroll") for (int k = 0; k < 2; ++k) dst[m][k] = *(const LAS bf16x8*)(lds + PG8_SA(b, h) + aoff + m * 2048 + k * 1024); } while (0)
#define PG8_LDB(dst, b, h) do { _Pragma("unroll") for (int n = 0; n < 2; ++n) _Pragma("unroll") for (int k = 0; k < 2; ++k) dst[n][k] = *(const LAS bf16x8*)(lds + PG8_SB(b, h) + boff + n * 2048 + k * 1024); } while (0)
#define PG8_MMA(ai, bj, At, Bt) do { __builtin_amdgcn_s_setprio(1); _Pragma("unroll") for (int m = 0; m < 4; ++m) _Pragma("unroll") for (int n = 0; n < 2; ++n) _Pragma("unroll") for (int k = 0; k < 2; ++k) \
        acc[ai][bj][m][n] = __builtin_amdgcn_mfma_f32_16x16x32_bf16(Bt[n][k], At[m][k], acc[ai][bj][m][n], 0, 0, 0); __builtin_amdgcn_s_setprio(0); } while (0)
#define PG8_WAIT_V(n) asm volatile("s_waitcnt vmcnt(" #n ")" ::: "memory")
#define PG8_WAIT_L(n) asm volatile("s_waitcnt lgkmcnt(" #n ")" ::: "memory")
#define PG8_BAR __builtin_amdgcn_s_barrier()
#define PG8_SCHED __builtin_amdgcn_sched_barrier(0)
#define PG8_AOFFS(dst, un) do { _Pragma("unroll") for (int _h = 0; _h < 2; ++_h) _Pragma("unroll") for (int _i = 0; _i < 2; ++_i) { \
        const int _row = S.arow(un, _h * HALF + RA[_i]); dst[_h][_i] = (unsigned)((size_t)_row * g.lda + CA[_i]) * 2u; } } while (0)
#define PG8_STAGE_A(bufoff, gbase, h, offs) do { _Pragma("unroll") for (int _i = 0; _i < 2; ++_i) { \
        const char* _src = Sched::GATHER ? (const char*)(gbase) + (offs)[h][_i] : (const char*)(gbase) + (size_t)(h) * hstepA + voffA[_i]; \
        __builtin_amdgcn_global_load_lds((const unsigned*)_src, (LAS unsigned*)(lds + (bufoff) + ldsw + _i * 8192), 16, 0, 0); } } while (0)
    const size_t hstepA = (size_t)HALF * g.lda * 2, tstepA = 2 * hstepA;
    unsigned voffA[2];
#pragma unroll
    for (int i = 0; i < 2; ++i) voffA[i] = (unsigned)(RA[i] * g.lda + CA[i]) * 2u;
    Unit cur, nxt; int ui = 0;
    if (!S.next(0, cur)) return;
    f32x4 acc[2][2][4][2];
#pragma unroll
    for (int a = 0; a < 2; ++a)
#pragma unroll
        for (int b = 0; b < 2; ++b)
#pragma unroll
            for (int m = 0; m < 4; ++m)
#pragma unroll
                for (int n = 0; n < 2; ++n) acc[a][b][m][n] = (f32x4){0.f, 0.f, 0.f, 0.f};
    bf16x8 At[4][2], B0[2][2], B1[2][2];
    unsigned offA[2][2] = {{0u, 0u}, {0u, 0u}}, noffA[2][2] = {{0u, 0u}, {0u, 0u}};
    if constexpr (Sched::GATHER) { PG8_AOFFS(offA, cur); }
    const char* cA = Sched::GATHER ? (const char*)g.A : (const char*)g.A + (size_t)cur.pm * tstepA;
    const char* cB = (const char*)g.Bt + (size_t)cur.pn * tstepB;
    PG8_STAGE(PG8_SB(0, 0), cB, voffB); PG8_STAGE(PG8_SB(0, 1), cB + hstepB, voffB); PG8_STAGE_A(PG8_SA(0, 0), cA, 0, offA); PG8_STAGE_A(PG8_SA(0, 1), cA, 1, offA);
    if (wr == 1) PG8_BAR;
    PG8_WAIT_V(2); PG8_BAR;
    PG8_STAGE(PG8_SB(1, 0), cB + kstep, voffB); PG8_STAGE_A(PG8_SA(1, 0), cA + kstep, 0, offA); PG8_STAGE(PG8_SB(1, 1), cB + hstepB + kstep, voffB);
    PG8_WAIT_V(6); PG8_BAR;
    for (;;) {
        const bool has_next = S.next(ui + 1, nxt);
        if constexpr (Sched::GATHER) {
            if (has_next) { PG8_AOFFS(noffA, nxt); }
            else {
#pragma unroll
                for (int h = 0; h < 2; ++h)
#pragma unroll
                    for (int i = 0; i < 2; ++i) noffA[h][i] = offA[h][i];
            }
        }
        const char* nA = Sched::GATHER ? cA : (has_next ? (const char*)g.A + (size_t)nxt.pm * tstepA : cA);
        const char* nB = has_next ? (const char*)g.Bt + (size_t)nxt.pn * tstepB : cB;
#pragma unroll 1
        for (int t = 0; t < nt; t += 2) {
            const bool last = (t == nt - 2);
            const char* a1 = cA + (size_t)(t + 1) * kstep;
            const char* a2 = last ? nA : cA + (size_t)(t + 2) * kstep; const char* b2 = last ? nB : cB + (size_t)(t + 2) * kstep;
            const char* a3 = a2 + kstep; const char* b3 = b2 + kstep;
            unsigned o2[2][2] = {{0u, 0u}, {0u, 0u}};
            if constexpr (Sched::GATHER) {
#pragma unroll
                for (int h = 0; h < 2; ++h)
#pragma unroll
                    for (int i = 0; i < 2; ++i) o2[h][i] = last ? noffA[h][i] : offA[h][i];
            }
            PG8_LDB(B0, 0, 0); PG8_LDB(B1, 0, 1); PG8_SCHED; PG8_LDA(At, 0, 0); PG8_STAGE_A(PG8_SA(1, 1), a1, 1, offA);
            PG8_WAIT_V(8); PG8_WAIT_L(0); PG8_BAR; PG8_MMA(0, 0, At, B0); PG8_MMA(0, 1, At, B1); PG8_BAR; PG8_SCHED;
            PG8_LDA(At, 0, 1); PG8_STAGE(PG8_SB(0, 0), b2, voffB); PG8_STAGE(PG8_SB(0, 1), b2 + hstepB, voffB); PG8_STAGE_A(PG8_SA(0, 0), a2, 0, o2);
            PG8_WAIT_V(8); PG8_WAIT_L(0); PG8_BAR; PG8_MMA(1, 0, At, B0); PG8_MMA(1, 1, At, B1); PG8_BAR; PG8_SCHED;
            PG8_LDB(B0, 1, 0); PG8_LDB(B1, 1, 1); PG8_SCHED; PG8_LDA(At, 1, 0); PG8_STAGE_A(PG8_SA(0, 1), a2, 1, o2);
            PG8_WAIT_V(8); PG8_WAIT_L(0); PG8_BAR; PG8_MMA(0, 0, At, B0); PG8_MMA(0, 1, At, B1); PG8_BAR; PG8_SCHED;
            PG8_LDA(At, 1, 1); PG8_STAGE(PG8_SB(1, 0), b3, voffB); PG8_STAGE(PG8_SB(1, 1), b3 + hstepB, voffB); PG8_STAGE_A(PG8_SA(1, 0), a3, 0, o2);
            PG8_WAIT_V(8); PG8_WAIT_L(0); PG8_BAR; PG8_MMA(1, 0, At, B0); PG8_MMA(1, 1, At, B1); PG8_BAR; PG8_SCHED;
        }
        if constexpr (ALIGN_EPI) { if (wr == 0) PG8_BAR; }
        E(acc, cur, wr, wc, fr, fq);
        if (!has_next) break;
#pragma unroll
        for (int a = 0; a < 2; ++a)
#pragma unroll
            for (int b = 0; b < 2; ++b)
#pragma unroll
                for (int m = 0; m < 4; ++m)
#pragma unroll
                    for (int n = 0; n < 2; ++n) acc[a][b][m][n] = (f32x4){0.f, 0.f, 0.f, 0.f};
        cur = nxt; cA = nA; cB = nB; ++ui;
        if constexpr (Sched::GATHER) {
#pragma unroll
            for (int h = 0; h < 2; ++h)
#pragma unroll
                for (int i = 0; i < 2; ++i) offA[h][i] = noffA[h][i];
        }
        if constexpr (ALIGN_EPI) { if (wr == 1) PG8_BAR; }
    }
    PG8_WAIT_V(0);
    if constexpr (!ALIGN_EPI) { if (wr == 0) PG8_BAR; }
    PG8_BAR;
#undef PG8_SA
#undef PG8_SB
#undef PG8_STAGE
#undef PG8_LDA
#undef PG8_LDB
#undef PG8_MMA
#undef PG8_WAIT_V
#undef PG8_WAIT_L
#undef PG8_BAR
#undef PG8_SCHED
#undef PG8_AOFFS
#undef PG8_STAGE_A
}
}
namespace pg8 {
typedef const f32x4 (&AccRef)[2][2][4][2];

struct EpiGemm1 {
    static constexpr bool PERM = false;
    bf16* H; bf16* KC; float* ssq; const float* cs; const float* sn;
    __device__ __forceinline__ void operator()(AccRef acc, const Unit& u, int wr, int wc, int fr, int fq) const {
        const int pn = u.pn;
        const float sc = (pn == 0 || (pn >= 2 && pn <= 4)) ? C_AB : 1.0f;
#pragma unroll
        for (int ai = 0; ai < 2; ++ai)
#pragma unroll
            for (int m = 0; m < 4; ++m) {
                const int r = u.pm * BM + ai * HALF + wr * 64 + m * 16 + fr;
                bf16* hrow = H + (size_t)r * NINP + pn * BM + wc * 32 + 4 * fq;
                const int nbj = (pn == 12) ? 1 : 2;
#pragma unroll
                for (int bj = 0; bj < 2; ++bj) if (bj < nbj)
#pragma unroll
                    for (int n = 0; n < 2; ++n) { const f32x4 v = acc[ai][bj][m][n] * sc; v2u w; w.x = cvt_pk_bf16(v[0], v[1]); w.y = cvt_pk_bf16(v[2], v[3]);
                        *(v2u*)(hrow + bj * HALF + n * 16) = w; }
                if (pn >= 11) {
                    float s = 0.f;
#pragma unroll
                    for (int bj = 0; bj < 2; ++bj) if (bj < nbj)
#pragma unroll
                        for (int n = 0; n < 2; ++n) { const f32x4 v = acc[ai][bj][m][n]; s += (v[0] * v[0] + v[1] * v[1]) + (v[2] * v[2] + v[3] * v[3]); }
                    s += __shfl_xor(s, 16); s += __shfl_xor(s, 32);
                    if (fq == 0) ssq[(size_t)r * 8 + (pn - 11) * 4 + wc] = s;
                    if (pn == 12 && wc == 0) {
                        const f32x4 x1 = acc[ai][1][m][0], x2 = acc[ai][1][m][1];
                        const f32x4 c = *(const f32x4*)(cs + (size_t)r * 16 + 4 * fq), sv = *(const f32x4*)(sn + (size_t)r * 16 + 4 * fq);
                        const f32x4 o1 = x1 * c - x2 * sv, o2 = x1 * sv + x2 * c;
                        v2u w1, w2; w1.x = cvt_pk_bf16(o1[0], o1[1]); w1.y = cvt_pk_bf16(o1[2], o1[3]); w2.x = cvt_pk_bf16(o2[0], o2[1]); w2.y = cvt_pk_bf16(o2[2], o2[3]);
                        bf16* kr = KC + (size_t)r * 768 + 64 + 4 * fq;
#pragma unroll
                        for (int h = 0; h < 8; ++h) { *(v2u*)(kr + h * 96) = w1; *(v2u*)(kr + h * 96 + 16) = w2; }
                    }
                }
            }
    }
};

struct EpiUpQ {
    static constexpr bool PERM = false;
    bf16* QC; const float* ssq; const float* cs; const float* sn;
    __device__ __forceinline__ void operator()(AccRef acc, const Unit& u, int wr, int wc, int fr, int fq) const {
#pragma unroll
        for (int ai = 0; ai < 2; ++ai)
#pragma unroll
            for (int m = 0; m < 4; ++m) {
                const int r = u.pm * BM + ai * HALF + wr * 64 + m * 16 + fr;
                const f32x4 sq = *(const f32x4*)(ssq + (size_t)r * 8);
                const float rs = C_MLA / sqrtf(((sq[0] + sq[1]) + (sq[2] + sq[3])) * (1.0f / 256.0f) + 1e-6f);
#pragma unroll
                for (int bj = 0; bj < 2; ++bj) {
                    const int cb = u.pn * BM + bj * HALF + wc * 32;
                    f32x4 v0 = acc[ai][bj][m][0] * rs, v1 = acc[ai][bj][m][1] * rs;
                    if (cb % 96 == 64) {
                        const f32x4 c = *(const f32x4*)(cs + (size_t)r * 16 + 4 * fq), sv = *(const f32x4*)(sn + (size_t)r * 16 + 4 * fq);
                        const f32x4 o1 = v0 * c - v1 * sv, o2 = v0 * sv + v1 * c; v0 = o1; v1 = o2;
                    }
                    v2u w0, w1; w0.x = cvt_pk_bf16(v0[0], v0[1]); w0.y = cvt_pk_bf16(v0[2], v0[3]); w1.x = cvt_pk_bf16(v1[0], v1[1]); w1.y = cvt_pk_bf16(v1[2], v1[3]);
                    bf16* q = QC + (size_t)r * 768 + cb + 4 * fq;
                    *(v2u*)q = w0; *(v2u*)(q + 16) = w1;
                }
            }
    }
};

struct EpiUpKV {
    static constexpr bool PERM = true;
    bf16* KC; bf16* VC; const float* ssq;
    __device__ __forceinline__ void operator()(AccRef acc, const Unit& u, int wr, int wc, int fr, int fq) const {
#pragma unroll
        for (int ai = 0; ai < 2; ++ai)
#pragma unroll
            for (int m = 0; m < 4; ++m) {
                const int r = u.pm * BM + ai * HALF + wr * 64 + m * 16 + fr;
                const f32x4 sq = *(const f32x4*)(ssq + (size_t)r * 8 + 4);
                const float rs = 1.0f / sqrtf(((sq[0] + sq[1]) + (sq[2] + sq[3])) * (1.0f / 128.0f) + 1e-6f);
#pragma unroll
                for (int bj = 0; bj < 2; ++bj) {
                    const int head = u.pn * 2 + bj, off = wc * 32 + 8 * fq;
                    const f32x4 v0 = acc[ai][bj][m][0] * rs, v1 = acc[ai][bj][m][1] * rs;
                    v4u w; w.x = cvt_pk_bf16(v0[0], v0[1]); w.y = cvt_pk_bf16(v0[2], v0[3]); w.z = cvt_pk_bf16(v1[0], v1[1]); w.w = cvt_pk_bf16(v1[2], v1[3]);
                    if (wc < 2) *(v4u*)(KC + (size_t)r * 768 + head * 96 + off) = w;
                    else        *(v4u*)(VC + (size_t)r * 512 + head * 64 + (off - 64)) = w;
                }
            }
    }
};

struct EpiOut {
    static constexpr bool PERM = false;
    const bf16* X; float* Z;
    __device__ __forceinline__ void operator()(AccRef acc, const Unit& u, int wr, int wc, int fr, int fq) const {
#pragma unroll
        for (int ai = 0; ai < 2; ++ai)
#pragma unroll
            for (int m = 0; m < 4; ++m) {
                const size_t off = (size_t)(u.pm * BM + ai * HALF + wr * 64 + m * 16 + fr) * D + u.pn * BM + wc * 32 + 4 * fq;
#pragma unroll
                for (int bj = 0; bj < 2; ++bj)
#pragma unroll
                    for (int n = 0; n < 2; ++n) { const v2u xw = *(const v2u*)(X + off + bj * HALF + n * 16);
                        const f32x4 xv = {bf2f((bf16)(xw.x & 0xffffu)), bf2f((bf16)(xw.x >> 16)), bf2f((bf16)(xw.y & 0xffffu)), bf2f((bf16)(xw.y >> 16))};
                        *(f32x4*)(Z + off + bj * HALF + n * 16) = xv * ALPHA + acc[ai][bj][m][n]; }
            }
    }
};

struct MoeOrder {
    static constexpr bool GATHER = true;
    const volatile LAS int* tstart;
    const volatile LAS int* cnts;
    const int* list_tok;
    int npn, G, c;
    __device__ bool next(int i, Unit& u) const {
        const long L = (long)i * G + c; const int nun = tstart[32] * npn; if (L >= nun) return false;
        const int rt = (int)L / npn, p = (int)L % npn; int e = 0;
        for (; e < 31; ++e) if (tstart[e + 1] > rt) break;
        u.pm = rt; u.pn = e * npn + p; u.e = e; u.lrt = rt - tstart[e]; return true;
    }
    __device__ __forceinline__ int arow(const Unit& u, int r) const { const int idx = u.lrt * BM + r; return idx < cnts[u.e] ? list_tok[(size_t)u.e * T + idx] : 0; }
};
struct MoeOrderDense : MoeOrder { static constexpr bool GATHER = false; };

struct EpiMoe1 {
    static constexpr bool PERM = true;
    bf16* HM;
    __device__ __forceinline__ void operator()(AccRef acc, const Unit& u, int wr, int wc, int fr, int fq) const {
        const int pl = u.pn & 1;
#pragma unroll
        for (int ai = 0; ai < 2; ++ai)
#pragma unroll
            for (int m = 0; m < 4; ++m) {
                const int r = u.pm * BM + ai * HALF + wr * 64 + m * 16 + fr;
                float o[8];
#pragma unroll
                for (int n = 0; n < 2; ++n)
#pragma unroll
                    for (int j = 0; j < 4; ++j) { const float gt = acc[ai][0][m][n][j], up = acc[ai][1][m][n][j];
                        o[n * 4 + j] = gt * __builtin_amdgcn_rcpf(1.0f + __builtin_amdgcn_exp2f(-gt * LOG2E)) * up; }
                v4u w; w.x = cvt_pk_bf16(o[0], o[1]); w.y = cvt_pk_bf16(o[2], o[3]); w.z = cvt_pk_bf16(o[4], o[5]); w.w = cvt_pk_bf16(o[6], o[7]);
                *(v4u*)(HM + (size_t)r * DEXP + pl * HALF + wc * 32 + 8 * fq) = w;
            }
    }
};
struct EpiMoe2 {
    static constexpr bool PERM = true;
    bf16* YS; const int* list_dst; const float* list_w; const volatile LAS int* cnts;
    __device__ __forceinline__ void operator()(AccRef acc, const Unit& u, int wr, int wc, int fr, int fq) const {
        const int pl = u.pn & 3; const int cnt = cnts[u.e];
#pragma unroll
        for (int ai = 0; ai < 2; ++ai)
#pragma unroll
            for (int m = 0; m < 4; ++m) {
                const int idx = u.lrt * BM + ai * HALF + wr * 64 + m * 16 + fr;
                if (idx < cnt) {
                    const int dst = list_dst[(size_t)u.e * T + idx]; const float wg = list_w[(size_t)u.e * T + idx];
                    bf16* y = YS + (size_t)dst * D + pl * BM + wc * 32 + 8 * fq;
#pragma unroll
                    for (int bj = 0; bj < 2; ++bj) { const f32x4 v0 = acc[ai][bj][m][0] * wg, v1 = acc[ai][bj][m][1] * wg;
                        v4u w; w.x = cvt_pk_bf16(v0[0], v0[1]); w.y = cvt_pk_bf16(v0[2], v0[3]); w.z = cvt_pk_bf16(v1[0], v1[1]); w.w = cvt_pk_bf16(v1[2], v1[3]);
                        *(v4u*)(y + bj * HALF) = w; }
                }
            }
    }
};
}
namespace att {
__device__ __forceinline__ int crow(int r, int hi) { return (r & 3) + 8 * (r >> 2) + 4 * hi; }
typedef short v4i16_t __attribute__((ext_vector_type(4)));
__device__ __forceinline__ s16x4 vtr(const LAS unsigned char* p) { return __builtin_bit_cast(s16x4, __builtin_amdgcn_ds_read_tr16_b64_v4i16((LAS v4i16_t*)p)); }
__device__ __forceinline__ void glds16(const void* gsrc, unsigned lds_dst) { unsigned keep;
    asm volatile("s_mov_b32 %0, m0\n\ts_mov_b32 m0, %2\n\ts_nop 0\n\tglobal_load_lds_dwordx4 %1, off\n\ts_mov_b32 m0, %0" : "=&s"(keep) : "v"(gsrc), "s"(lds_dst) : "memory"); }
#define ATT_WAIT_BAR(N) asm volatile("s_waitcnt vmcnt(" #N ") lgkmcnt(0)\n\ts_barrier" ::: "memory")

struct AttnP {
    const bf16* Q; long qstr;
    const bf16* K; long kstr;
    const bf16* V; long vstr;
    bf16* O; long ostr;
    float* LSE; long lstr;
    int q0;
    int k0;
    int nt;
    float m_init, l_init;
    int W;
};

template <int DQK> struct Lay { static constexpr int NSLOT = 3, KB = DQK / 8 * 1024, VOFF = NSLOT * KB, BOFF = VOFF + NSLOT * 8192, BYTES = BOFF + 1024; };
constexpr float THR = 8.0f;

template <int DQK, int MODE>
__device__ __forceinline__ void attn_unit(const AttnP& a, LAS unsigned char* lds) {
    typedef Lay<DQK> L;
    constexpr int NS = DQK / 16;
    int tid = threadIdx.x; asm volatile("" : "+v"(tid));
    const int lane = tid & 63, r32 = lane & 31, hi = lane >> 5; const int wid = __builtin_amdgcn_readfirstlane(tid >> 6);
    const LAS float* btab = (const LAS float*)(lds + L::BOFF);
    const int qs = a.q0 + wid * 32 + r32;
    const int qa = a.q0 + wid * 32, qb = qa + 31;
    const int W = a.W;
    const unsigned lds0 = (unsigned)(uintptr_t)lds;
    const bool k2 = (DQK == 96) && (wid < 4);
    VM_WAIT();
#define ATT_DMA(t, s) do { const int ka_ = a.k0 + (t) * 64; int kr_ = ka_ + lane; kr_ = kr_ < 0 ? 0 : kr_; \
        const bf16* ks_ = a.K + (long)kr_ * a.kstr + wid * 8; \
        glds16(ks_, (unsigned)__builtin_amdgcn_readfirstlane(lds0 + (s) * L::KB + wid * 1024)); \
        if (k2) glds16(ks_ + 64, (unsigned)__builtin_amdgcn_readfirstlane(lds0 + (s) * L::KB + (8 + wid) * 1024)); \
        int vr_ = ka_ + 16 * (wid & 3) + (lane >> 2); vr_ = vr_ < 0 ? 0 : vr_; \
        glds16(a.V + (long)vr_ * a.vstr + (wid >> 2) * 32 + (lane & 3) * 8, (unsigned)__builtin_amdgcn_readfirstlane(lds0 + L::VOFF + (s) * 8192 + wid * 1024)); } while (0)
    ATT_DMA(0, 0);
    ATT_DMA(1, 1);
    bf16x8 qr[NS];
    { const bf16* qp = a.Q + (long)qs * a.qstr + hi * 8;
#pragma unroll
      for (int s = 0; s < NS; ++s) qr[s] = *(const bf16x8*)(qp + s * 16); }
    float m_run = a.m_init, l_run = (hi == 0) ? a.l_init : 0.f;
    f32x16 o0 = {}, o1 = {};
    int slot = 0;
    for (int t = 0; t < a.nt; ++t) {
        const int ka = a.k0 + t * 64;
        if (t + 1 < a.nt) { if (k2) ATT_WAIT_BAR(3); else ATT_WAIT_BAR(2); } else ATT_WAIT_BAR(0);
        { int s2 = slot + 2; s2 = s2 >= 3 ? s2 - 3 : s2; if (t + 2 < a.nt) ATT_DMA(t + 2, s2); }
        const LAS unsigned char* kb = lds + slot * L::KB + hi * 1024 + r32 * 16;
        const LAS unsigned char* vb = lds + L::VOFF + slot * 8192 + ((lane >> 4) & 1) * 32 + (lane & 3) * 8 + (4 * hi + ((lane & 15) >> 2)) * 64;
        slot = slot == 2 ? 0 : slot + 1;
        const int kz = ka + 63;
        bool any, full;
        if (MODE == 0) { any = (kz >= qa - W) && (ka <= qb) && (kz >= 0); full = false; }
        else           { any = (ka <= qb);                               full = (kz <= qa); }
        if (!any) continue;
        f32x16 p0 = {}, p1 = {};
#pragma unroll
        for (int s = 0; s < NS; ++s) {
            const bf16x8 k0f = *(const LAS bf16x8*)(kb + s * 2048), k1f = *(const LAS bf16x8*)(kb + s * 2048 + 512);
            p0 = __builtin_amdgcn_mfma_f32_32x32x16_bf16(k0f, qr[s], p0, 0, 0, 0);
            p1 = __builtin_amdgcn_mfma_f32_32x32x16_bf16(k1f, qr[s], p1, 0, 0, 0);
        }
        if (MODE == 0) {
#pragma unroll
            for (int r = 0; r < 16; ++r) {
                const int k_0 = ka + crow(r, hi), k_1 = k_0 + 32; const int d0 = qs - k_0, d1 = qs - k_1;
                const int c0 = d0 < 0 ? 0 : (d0 > W ? W : d0), c1 = d1 < 0 ? 0 : (d1 > W ? W : d1);
                const float b0 = btab[c0], b1 = btab[c1];
                p0[r] = (k_0 >= 0 && d0 >= 0 && d0 <= W) ? p0[r] + b0 : -INFINITY;
                p1[r] = (k_1 >= 0 && d1 >= 0 && d1 <= W) ? p1[r] + b1 : -INFINITY;
            }
        } else if (!full) {
#pragma unroll
            for (int r = 0; r < 16; ++r) { const int k_0 = ka + crow(r, hi); if (k_0 > qs) p0[r] = -INFINITY; if (k_0 + 32 > qs) p1[r] = -INFINITY; }
        }
        float mx = fmaxf(fmaxf(p0[0], p0[1]), p1[0]);
#pragma unroll
        for (int r = 2; r < 16; r += 2) mx = fmaxf(fmaxf(mx, p0[r]), p0[r + 1]);
#pragma unroll
        for (int r = 1; r < 15; r += 2) mx = fmaxf(fmaxf(mx, p1[r]), p1[r + 1]);
        mx = fmaxf(mx, p1[15]);
        { auto rr = __builtin_amdgcn_permlane32_swap(__float_as_uint(mx), __float_as_uint(mx), false, false); mx = fmaxf(__uint_as_float(rr[0]), __uint_as_float(rr[1])); }
        if (__any(mx > m_run + THR)) {
            const float m_new = fmaxf(m_run, mx);
            const float m_safe = (m_new == -INFINITY) ? 0.f : m_new;
            const float alpha = __builtin_amdgcn_exp2f(m_run - m_safe);
            m_run = m_new; l_run *= alpha;
#pragma unroll
            for (int r = 0; r < 16; ++r) { o0[r] *= alpha; o1[r] *= alpha; }
        }
        const float m_use = (m_run == -INFINITY) ? 0.f : m_run;
        float ls = 0.f;
#pragma unroll
        for (int r = 0; r < 16; ++r) { p0[r] = __builtin_amdgcn_exp2f(p0[r] - m_use); p1[r] = __builtin_amdgcn_exp2f(p1[r] - m_use); ls += p0[r] + p1[r]; }
        l_run += ls;
        bf16x8 pf[4];
#define ATT_PK(P, B) __builtin_bit_cast(bf16x8, (v4u){cvt_pk_bf16(P[B], P[B + 1]), cvt_pk_bf16(P[B + 2], P[B + 3]), cvt_pk_bf16(P[B + 4], P[B + 5]), cvt_pk_bf16(P[B + 6], P[B + 7])})
        pf[0] = ATT_PK(p0, 0); pf[1] = ATT_PK(p0, 8); pf[2] = ATT_PK(p1, 0); pf[3] = ATT_PK(p1, 8);
#undef ATT_PK
#pragma unroll
        for (int ks = 0; ks < 4; ++ks) {
            const s16x4 a_lo = vtr(vb + ks * 1024), a_hi = vtr(vb + ks * 1024 + 512);
            const s16x4 b_lo = vtr(vb + 4096 + ks * 1024), b_hi = vtr(vb + 4096 + ks * 1024 + 512);
            const bf16x8 va = (bf16x8){a_lo[0], a_lo[1], a_lo[2], a_lo[3], a_hi[0], a_hi[1], a_hi[2], a_hi[3]};
            const bf16x8 vb2 = (bf16x8){b_lo[0], b_lo[1], b_lo[2], b_lo[3], b_hi[0], b_hi[1], b_hi[2], b_hi[3]};
            o0 = __builtin_amdgcn_mfma_f32_32x32x16_bf16(va, pf[ks], o0, 0, 0, 0);
            o1 = __builtin_amdgcn_mfma_f32_32x32x16_bf16(vb2, pf[ks], o1, 0, 0, 0);
        }
    }
#undef ATT_DMA
    { auto rr = __builtin_amdgcn_permlane32_swap(__float_as_uint(l_run), __float_as_uint(l_run), false, false); l_run = __uint_as_float(rr[0]) + __uint_as_float(rr[1]); }
    const float inv = 1.0f / l_run;
    bf16* op = a.O + (long)qs * a.ostr + 4 * hi;
#pragma unroll
    for (int i = 0; i < 4; ++i) {
        v2u w0, w1; w0.x = cvt_pk_bf16(o0[4 * i] * inv, o0[4 * i + 1] * inv); w0.y = cvt_pk_bf16(o0[4 * i + 2] * inv, o0[4 * i + 3] * inv);
        w1.x = cvt_pk_bf16(o1[4 * i] * inv, o1[4 * i + 1] * inv); w1.y = cvt_pk_bf16(o1[4 * i + 2] * inv, o1[4 * i + 3] * inv);
        *(v2u*)(op + 8 * i) = w0; *(v2u*)(op + 32 + 8 * i) = w1;
    }
    if (a.LSE && hi == 0) a.LSE[(long)qs * a.lstr] = m_run + __builtin_amdgcn_logf(l_run);
    asm volatile("s_waitcnt lgkmcnt(0)\n\ts_barrier" ::: "memory");
}

struct LayM { static constexpr int NSLOT = 4, KB = 12288, VOFF = NSLOT * KB, BYTES = VOFF + NSLOT * 8192; };
#define ATT_SB() __builtin_amdgcn_sched_barrier(0)
#ifndef ATT_G0
#define ATT_G0(w) (((w) & 1) == 0)
#endif
__device__ __forceinline__ void attn_unit_mla(const AttnP& a, LAS unsigned char* lds) {
    typedef LayM L;
    constexpr int NS = 6;
    int tid = threadIdx.x; asm volatile("" : "+v"(tid));
    const int lane = tid & 63, r32 = lane & 31, hi = lane >> 5; const int wid = __builtin_amdgcn_readfirstlane(tid >> 6);
    const int qs = a.q0 + wid * 32 + r32;
    const int qa = a.q0 + wid * 32, qb = qa + 31;
    const unsigned lds0 = (unsigned)(uintptr_t)lds;
    const bool k2 = wid < 4;
    const bool g0 = ATT_G0(wid);
    bf16x8 qr[NS];
    { const bf16* qp = a.Q + (long)qs * a.qstr + hi * 8;
#pragma unroll
      for (int s = 0; s < NS; ++s) qr[s] = *(const bf16x8*)(qp + s * 16); }
    asm volatile("" : "+v"(qr[0]), "+v"(qr[1]), "+v"(qr[2]), "+v"(qr[3]), "+v"(qr[4]), "+v"(qr[5]));
    VM_WAIT();
#define ATT_DMA(t, s) do { const int ka_ = (t) * 64; \
        const bf16* ks_ = a.K + (long)(ka_ + lane) * a.kstr + wid * 8; \
        glds16(ks_, (unsigned)__builtin_amdgcn_readfirstlane(lds0 + (s) * L::KB + wid * 1024)); \
        if (k2) glds16(ks_ + 64, (unsigned)__builtin_amdgcn_readfirstlane(lds0 + (s) * L::KB + (8 + wid) * 1024)); \
        glds16(a.V + (long)(ka_ + 16 * (wid & 3) + (lane >> 2)) * a.vstr + (wid >> 2) * 32 + (lane & 3) * 8, (unsigned)__builtin_amdgcn_readfirstlane(lds0 + L::VOFF + (s) * 8192 + wid * 1024)); } while (0)
    ATT_DMA(0, 0); ATT_DMA(1, 1); ATT_DMA(2, 2);
    float m_run = -INFINITY, l_run = 0.f;
    f32x16 o0 = {}, o1 = {};
    const int kvoff = hi * 1024 + r32 * 16;
    const int vvoff = L::VOFF + ((lane >> 4) & 1) * 32 + (lane & 3) * 8 + (4 * hi + ((lane & 15) >> 2)) * 64;
    bf16x8 kf[2 * NS];
#define ATT_KLOAD(sl) do { const LAS unsigned char* kb_ = lds + (sl) * L::KB + kvoff; \
        _Pragma("unroll") for (int s = 0; s < NS; ++s) { kf[2 * s] = *(const LAS bf16x8*)(kb_ + s * 2048); kf[2 * s + 1] = *(const LAS bf16x8*)(kb_ + s * 2048 + 512); } } while (0)
#define ATT_PK(P, B) __builtin_bit_cast(bf16x8, (v4u){cvt_pk_bf16(P[B], P[B + 1]), cvt_pk_bf16(P[B + 2], P[B + 3]), cvt_pk_bf16(P[B + 4], P[B + 5]), cvt_pk_bf16(P[B + 6], P[B + 7])})
#define ATT_BARDMA(t) do { \
        if ((t) + 2 < a.nt) { if (k2) ATT_WAIT_BAR(3); else ATT_WAIT_BAR(2); } else ATT_WAIT_BAR(0);     \
        if ((t) + 3 < a.nt) ATT_DMA((t) + 3, ((t) + 3) & 3); } while (0)
#define ATT_VLOAD(sl) do { const LAS unsigned char* vb_ = lds + (sl) * 8192 + vvoff; \
        _Pragma("unroll") for (int ks = 0; ks < 4; ++ks) { vl[2 * ks] = vtr(vb_ + ks * 1024); vh[2 * ks] = vtr(vb_ + ks * 1024 + 512); vl[2 * ks + 1] = vtr(vb_ + 4096 + ks * 1024); vh[2 * ks + 1] = vtr(vb_ + 4096 + ks * 1024 + 512); } } while (0)
#define ATT_VF(i) (bf16x8){vl[i][0], vl[i][1], vl[i][2], vl[i][3], vh[i][0], vh[i][1], vh[i][2], vh[i][3]}
#define ATT_MFMA_VALU(NM, NV, NT) do { _Pragma("unroll") for (int g_ = 0; g_ < (NM); ++g_) { __builtin_amdgcn_sched_group_barrier(0x008, 1, 0); if (NT) __builtin_amdgcn_sched_group_barrier(0x400, (NT), 0); __builtin_amdgcn_sched_group_barrier(0x002, (NV), 0); } } while (0)
#define ATT_STEP(PC0, PC1, PN0, PN1, t, FIRST) do { const int ka = (t) * 64; \
        ATT_BARDMA(t); \
        ATT_KLOAD(((t) + 1) & 3); \
        ATT_SB(); \
        if (ka + 63 > qa) { _Pragma("unroll") for (int r = 0; r < 16; ++r) { const int k_0 = ka + crow(r, hi); if (k_0 > qs) PC0[r] = -INFINITY; if (k_0 + 32 > qs) PC1[r] = -INFINITY; } } \
          \
        if (!(FIRST)) { _Pragma("unroll") for (int ks = 0; ks < 4; ++ks) { o0 = __builtin_amdgcn_mfma_f32_32x32x16_bf16(ATT_VF(2 * ks), pf[ks], o0, 0, 0, 0); o1 = __builtin_amdgcn_mfma_f32_32x32x16_bf16(ATT_VF(2 * ks + 1), pf[ks], o1, 0, 0, 0); } } \
        float mx = fmaxf(fmaxf(PC0[0], PC0[1]), PC1[0]); \
        _Pragma("unroll") for (int r = 2; r < 16; r += 2) mx = fmaxf(fmaxf(mx, PC0[r]), PC0[r + 1]); \
        _Pragma("unroll") for (int r = 1; r < 15; r += 2) mx = fmaxf(fmaxf(mx, PC1[r]), PC1[r + 1]); \
        mx = fmaxf(mx, PC1[15]); \
        { auto rr = __builtin_amdgcn_permlane32_swap(__float_as_uint(mx), __float_as_uint(mx), false, false); mx = fmaxf(__uint_as_float(rr[0]), __uint_as_float(rr[1])); } \
        if (!(FIRST)) ATT_MFMA_VALU(8, 4, 0); \
        ATT_SB(); \
        if (__any(mx > m_run + THR)) { const float m_new = fmaxf(m_run, mx); const float alpha = __builtin_amdgcn_exp2f(m_run - m_new); m_run = m_new; l_run *= alpha; \
            _Pragma("unroll") for (int r = 0; r < 16; ++r) { o0[r] *= alpha; o1[r] *= alpha; } } \
        ATT_VLOAD((t) & 3); \
        ATT_SB(); \
          \
        PN0 = (f32x16){}; PN1 = (f32x16){}; \
        _Pragma("unroll") for (int s = 0; s < NS; ++s) { PN0 = __builtin_amdgcn_mfma_f32_32x32x16_bf16(kf[2 * s], qr[s], PN0, 0, 0, 0); PN1 = __builtin_amdgcn_mfma_f32_32x32x16_bf16(kf[2 * s + 1], qr[s], PN1, 0, 0, 0); } \
        float ls = 0.f; \
        _Pragma("unroll") for (int r = 0; r < 16; ++r) { PC0[r] = __builtin_amdgcn_exp2f(PC0[r] - m_run); PC1[r] = __builtin_amdgcn_exp2f(PC1[r] - m_run); ls += PC0[r] + PC1[r]; } \
        l_run += ls; \
        pf[0] = ATT_PK(PC0, 0); pf[1] = ATT_PK(PC0, 8); pf[2] = ATT_PK(PC1, 0); pf[3] = ATT_PK(PC1, 8); \
        ATT_MFMA_VALU(12, 7, 3); \
        ATT_SB(); } while (0)
    if (k2) ATT_WAIT_BAR(6); else ATT_WAIT_BAR(4);
    ATT_KLOAD(0);
    f32x16 pA0 = {}, pA1 = {}, pB0, pB1; s16x4 vl[8], vh[8]; bf16x8 pf[4];
#pragma unroll
    for (int s = 0; s < NS; ++s) { pA0 = __builtin_amdgcn_mfma_f32_32x32x16_bf16(kf[2 * s], qr[s], pA0, 0, 0, 0); pA1 = __builtin_amdgcn_mfma_f32_32x32x16_bf16(kf[2 * s + 1], qr[s], pA1, 0, 0, 0); }
    ATT_STEP(pA0, pA1, pB0, pB1, 0, true);
    ATT_STEP(pB0, pB1, pA0, pA1, 1, false);
    for (int t = 2; t < a.nt; t += 2) {
        ATT_STEP(pA0, pA1, pB0, pB1, t, false);
        ATT_STEP(pB0, pB1, pA0, pA1, t + 1, false);
    }
#pragma unroll
    for (int ks = 0; ks < 4; ++ks) { o0 = __builtin_amdgcn_mfma_f32_32x32x16_bf16(ATT_VF(2 * ks), pf[ks], o0, 0, 0, 0); o1 = __builtin_amdgcn_mfma_f32_32x32x16_bf16(ATT_VF(2 * ks + 1), pf[ks], o1, 0, 0, 0); }
#undef ATT_BARDMA
#undef ATT_VLOAD
#undef ATT_VF
#undef ATT_MFMA_VALU
#undef ATT_STEP
#undef ATT_DMA
#undef ATT_KLOAD
#undef ATT_PK
    { auto rr = __builtin_amdgcn_permlane32_swap(__float_as_uint(l_run), __float_as_uint(l_run), false, false); l_run = __uint_as_float(rr[0]) + __uint_as_float(rr[1]); }
    const float inv = 1.0f / l_run;
    bf16* op = a.O + (long)qs * a.ostr + 4 * hi;
#pragma unroll
    for (int i = 0; i < 4; ++i) {
        v2u w0, w1; w0.x = cvt_pk_bf16(o0[4 * i] * inv, o0[4 * i + 1] * inv); w0.y = cvt_pk_bf16(o0[4 * i + 2] * inv, o0[4 * i + 3] * inv);
        w1.x = cvt_pk_bf16(o1[4 * i] * inv, o1[4 * i + 1] * inv); w1.y = cvt_pk_bf16(o1[4 * i + 2] * inv, o1[4 * i + 3] * inv);
        *(v2u*)(op + 8 * i) = w0; *(v2u*)(op + 32 + 8 * i) = w1;
    }
    asm volatile("s_waitcnt lgkmcnt(0)\n\ts_barrier" ::: "memory");
}

struct BandP { const bf16* Q; const bf16* K; const bf16* V; long str; bf16* O; long ostr; float* LSE; long lstr; int qa; float m_init, l_init; };
constexpr int BAND_WLDS = 16384;
__device__ __forceinline__ void band_item(const BandP& a, const LAS float* bt, LAS unsigned char* wl) {
    int tid = threadIdx.x; asm volatile("" : "+v"(tid));
    const int lane = tid & 63, r32 = lane & 31, hi = lane >> 5;
    const unsigned wl0 = (unsigned)__builtin_amdgcn_readfirstlane((unsigned)(uintptr_t)wl);
    const int qs = a.qa + r32;
    const int c0 = a.qa >= 128 ? 0 : (128 - a.qa) >> 5;
    asm volatile("s_waitcnt vmcnt(0) lgkmcnt(0)" ::: "memory");
#define BAND_VDMA(c) do { const bf16* vp_ = a.V + (long)(a.qa - 128 + 32 * (c) + (lane >> 3)) * a.str + (lane & 7) * 8; \
        _Pragma("unroll") for (int i = 0; i < 4; ++i) glds16(vp_ + (long)(8 * i) * a.str, wl0 + ((c) & 3) * 4096 + i * 1024); } while (0)
    if (c0 <= 0) BAND_VDMA(0); if (c0 <= 1) BAND_VDMA(1); if (c0 <= 2) BAND_VDMA(2); if (c0 <= 3) BAND_VDMA(3);
    if (c0 >= 1) BAND_VDMA(4);
    bf16x8 qr[4], kf[5][4];
    { const bf16* qp = a.Q + (long)qs * a.str + hi * 8;
#pragma unroll
      for (int s = 0; s < 4; ++s) qr[s] = *(const bf16x8*)(qp + s * 16); }
#pragma unroll
    for (int c = 0; c < 5; ++c) {
        if (c >= c0) { const bf16* kp = a.K + (long)(a.qa - 128 + 32 * c + r32) * a.str + hi * 8;
#pragma unroll
            for (int s = 0; s < 4; ++s) kf[c][s] = *(const bf16x8*)(kp + s * 16); }
        else {
#pragma unroll
            for (int s = 0; s < 4; ++s) kf[c][s] = (bf16x8){0, 0, 0, 0, 0, 0, 0, 0}; }
    }
    float m_run = a.m_init, l_run = (hi == 0) ? a.l_init : 0.f;
    f32x16 o0 = {}, o1 = {};
    const int vvoff = (4 * hi + ((lane & 15) >> 2)) * 128 + ((lane >> 4) & 1) * 32 + (lane & 3) * 8;
    const LAS float* btl = bt + (r32 - 4 * hi + 31 + 128 - 27);
#define ATT_PK(P, B) __builtin_bit_cast(bf16x8, (v4u){cvt_pk_bf16(P[B], P[B + 1]), cvt_pk_bf16(P[B + 2], P[B + 3]), cvt_pk_bf16(P[B + 4], P[B + 5]), cvt_pk_bf16(P[B + 6], P[B + 7])})
#define BAND_VF(i) (bf16x8){vl[i][0], vl[i][1], vl[i][2], vl[i][3], vh[i][0], vh[i][1], vh[i][2], vh[i][3]}
#define BAND_CHUNK(C, WAITSTR) do { if ((C) >= c0) { \
        f32x16 p = {}; \
        _Pragma("unroll") for (int s = 0; s < 4; ++s) p = __builtin_amdgcn_mfma_f32_32x32x16_bf16(kf[C][s], qr[s], p, 0, 0, 0); \
        asm volatile(WAITSTR ::: "memory"); \
        const LAS unsigned char* vb = wl + ((C) & 3) * 4096 + vvoff; \
        s16x4 vl[4], vh[4]; \
        _Pragma("unroll") for (int k2 = 0; k2 < 2; ++k2) { vl[2 * k2] = vtr(vb + k2 * 2048); vh[2 * k2] = vtr(vb + k2 * 2048 + 1024); vl[2 * k2 + 1] = vtr(vb + 64 + k2 * 2048); vh[2 * k2 + 1] = vtr(vb + 64 + k2 * 2048 + 1024); } \
        const LAS float* bc = btl - 32 * (C); \
        _Pragma("unroll") for (int r = 0; r < 16; ++r) p[r] += bc[27 - (r & 3) - 8 * (r >> 2)]; \
        float mx = fmaxf(p[0], p[1]); \
        _Pragma("unroll") for (int r = 2; r < 16; r += 2) mx = fmaxf(fmaxf(mx, p[r]), p[r + 1]); \
        { auto rr = __builtin_amdgcn_permlane32_swap(__float_as_uint(mx), __float_as_uint(mx), false, false); mx = fmaxf(__uint_as_float(rr[0]), __uint_as_float(rr[1])); } \
        if (__any(mx > m_run + THR)) { const float m_new = fmaxf(m_run, mx); const float m_safe = (m_new == -INFINITY) ? 0.f : m_new; const float alpha = __builtin_amdgcn_exp2f(m_run - m_safe); m_run = m_new; l_run *= alpha; \
            _Pragma("unroll") for (int r = 0; r < 16; ++r) { o0[r] *= alpha; o1[r] *= alpha; } } \
        const float m_use = (m_run == -INFINITY) ? 0.f : m_run; \
        float ls = 0.f; \
        _Pragma("unroll") for (int r = 0; r < 16; ++r) { p[r] = __builtin_amdgcn_exp2f(p[r] - m_use); ls += p[r]; } \
        l_run += ls; \
        const bf16x8 pf0 = ATT_PK(p, 0), pf1 = ATT_PK(p, 8); \
        o0 = __builtin_amdgcn_mfma_f32_32x32x16_bf16(BAND_VF(0), pf0, o0, 0, 0, 0); \
        o1 = __builtin_amdgcn_mfma_f32_32x32x16_bf16(BAND_VF(1), pf0, o1, 0, 0, 0); \
        o0 = __builtin_amdgcn_mfma_f32_32x32x16_bf16(BAND_VF(2), pf1, o0, 0, 0, 0); \
        o1 = __builtin_amdgcn_mfma_f32_32x32x16_bf16(BAND_VF(3), pf1, o1, 0, 0, 0); \
        if ((C) == 0) { asm volatile("s_waitcnt lgkmcnt(0)" ::: "memory"); BAND_VDMA(4); }     \
    } } while (0)
    BAND_CHUNK(0, "s_waitcnt vmcnt(16)"); BAND_CHUNK(1, "s_waitcnt vmcnt(12)"); BAND_CHUNK(2, "s_waitcnt vmcnt(8)"); BAND_CHUNK(3, "s_waitcnt vmcnt(4)"); BAND_CHUNK(4, "s_waitcnt vmcnt(0)");
#undef BAND_CHUNK
#undef ATT_PK
#undef BAND_VF
#undef BAND_VDMA
    { auto rr = __builtin_amdgcn_permlane32_swap(__float_as_uint(l_run), __float_as_uint(l_run), false, false); l_run = __uint_as_float(rr[0]) + __uint_as_float(rr[1]); }
    const float inv = 1.0f / l_run;
    bf16* op = a.O + (long)qs * a.ostr + 4 * hi;
#pragma unroll
    for (int i = 0; i < 4; ++i) {
        v2u w0, w1; w0.x = cvt_pk_bf16(o0[4 * i] * inv, o0[4 * i + 1] * inv); w0.y = cvt_pk_bf16(o0[4 * i + 2] * inv, o0[4 * i + 3] * inv);
        w1.x = cvt_pk_bf16(o1[4 * i] * inv, o1[4 * i + 1] * inv); w1.y = cvt_pk_bf16(o1[4 * i + 2] * inv, o1[4 * i + 3] * inv);
        *(v2u*)(op + 8 * i) = w0; *(v2u*)(op + 32 + 8 * i) = w1;
    }
    if (a.LSE && hi == 0) a.LSE[(long)qs * a.lstr] = m_run + __builtin_amdgcn_logf(l_run);
}
}
__device__ __forceinline__ void transpose_item(const float* W, int ldw, int k0, int n0, bf16* WT, int ldt, int dst_row0, const float* kscale, LAS float* scr, int lane) {
#pragma unroll 8
    for (int i = 0; i < 32; ++i) { const int kk = 2 * i + (lane >> 5); float v = W[(size_t)(k0 + kk) * ldw + n0 + (lane & 31)]; if (kscale) v *= kscale[k0 + kk]; scr[kk * 33 + (lane & 31)] = v; }
    LDS_WAIT(); asm volatile("" ::: "memory");
    const int c = lane & 7;
#pragma unroll
    for (int j = 0; j < 4; ++j) { const int n = (lane >> 3) + 8 * j; const LAS float* s = scr + (8 * c) * 33 + n;
        v4u o; o.x = pk2(s[0 * 33], s[1 * 33]); o.y = pk2(s[2 * 33], s[3 * 33]); o.z = pk2(s[4 * 33], s[5 * 33]); o.w = pk2(s[6 * 33], s[7 * 33]);
        *(GAS v4u*)(WT + (size_t)(dst_row0 + n) * ldt + k0 + 8 * c) = o; }
    LDS_WAIT(); asm volatile("" ::: "memory");
}

__device__ __forceinline__ int t5_bucket(int dist) {
    if (dist < 16) return dist;
    const float v = logf((float)dist / 16.0f) / 4.852030263919617f * 16.0f;
    const int large = 16 + (int)v;
    return large < 31 ? large : 31;
}

struct RouterOut { int e0, e1; float w0, w1; };
__device__ __forceinline__ RouterOut route_row(const f32x4 (&v)[4], const float* wrg, const float* brg, const float* wre, const float* bre, int lane) {
    float g[4] = {0.f, 0.f, 0.f, 0.f};
#pragma unroll
    for (int j = 0; j < 4; ++j)
#pragma unroll
        for (int i = 0; i < 4; ++i) { const f32x4 w = *(const GAS f32x4*)(wrg + (size_t)(256 * j + 4 * lane + i) * 4); const float x = v[j][i];
            g[0] += x * w[0]; g[1] += x * w[1]; g[2] += x * w[2]; g[3] += x * w[3]; }
#pragma unroll
    for (int k = 0; k < 4; ++k) g[k] = wave_sum(g[k]) + brg[k];
    int grp = 0; float gm = g[0];
#pragma unroll
    for (int k = 1; k < 4; ++k) if (g[k] > gm) { gm = g[k]; grp = k; }
    float gs = 0.f;
#pragma unroll
    for (int k = 0; k < 4; ++k) gs += expf(g[k] - gm);
    const float pgrp = 1.0f / gs;
    float e[8] = {0.f, 0.f, 0.f, 0.f, 0.f, 0.f, 0.f, 0.f};
    const float* we = wre + (size_t)grp * D * 8;
#pragma unroll
    for (int j = 0; j < 4; ++j)
#pragma unroll
        for (int i = 0; i < 4; ++i) { const GAS f32x4* wp = (const GAS f32x4*)(we + (size_t)(256 * j + 4 * lane + i) * 8); const f32x4 wa = wp[0], wb = wp[1]; const float x = v[j][i];
            e[0] += x * wa[0]; e[1] += x * wa[1]; e[2] += x * wa[2]; e[3] += x * wa[3]; e[4] += x * wb[0]; e[5] += x * wb[1]; e[6] += x * wb[2]; e[7] += x * wb[3]; }
#pragma unroll
    for (int k = 0; k < 8; ++k) e[k] = wave_sum(e[k]) + bre[grp * 8 + k];
    int i0 = 0; float v0 = e[0];
#pragma unroll
    for (int k = 1; k < 8; ++k) if (e[k] > v0) { v0 = e[k]; i0 = k; }
    int i1 = -1; float v1 = -INFINITY;
#pragma unroll
    for (int k = 0; k < 8; ++k) if (k != i0 && e[k] > v1) { v1 = e[k]; i1 = k; }
    const float t = expf(v1 - v0);
    RouterOut r; r.e0 = grp * 8 + i0; r.e1 = grp * 8 + i1; r.w0 = pgrp / (1.0f + t); r.w1 = pgrp * t / (1.0f + t);
    return r;
}
constexpr size_t MiB = 1u << 20;
constexpr size_t WS_CTL = 0, CTL_ZERO_BYTES = 1 * MiB;
constexpr size_t WS_WIN = 2 * MiB;
constexpr size_t WS_WOUT = 28 * MiB;
constexpr size_t WS_WUQ = 36 * MiB;
constexpr size_t WS_WUKV = 38 * MiB;
constexpr size_t WS_WT = 43 * MiB;
constexpr size_t WS_COS = 40 * MiB, WS_SIN = 41 * MiB, WS_BT = 42 * MiB;
constexpr size_t WS_WGU = 44 * MiB;
constexpr size_t WS_WD = 76 * MiB;
constexpr size_t WS_XA = 92 * MiB;
constexpr size_t WS_X1 = 156 * MiB;
constexpr size_t WS_XB = 220 * MiB;
constexpr size_t WS_H = 252 * MiB;
constexpr size_t WS_Z = WS_H;
constexpr size_t WS_HM = WS_H + 64 * MiB;
constexpr size_t WS_QC = 356 * MiB, WS_KC = 380 * MiB, WS_VC = 404 * MiB;
constexpr size_t WS_YS = WS_QC;
constexpr size_t WS_OBG = 420 * MiB, WS_LSE = 444 * MiB;
constexpr size_t WS_OCAT = 446 * MiB;
constexpr size_t WS_LTOK = 478 * MiB, WS_LW = 480 * MiB, WS_LDST = 482 * MiB;
constexpr size_t WS_TOKE = 484 * MiB, WS_TOKW = WS_TOKE + 512 * 1024;
constexpr size_t WS_SSQ = 485 * MiB;
constexpr size_t WS_END = 486 * MiB;
constexpr int CW_DBG = 8;
constexpr int CW_BAR = 4096;
constexpr int CW_CNT = 16384;
constexpr int RING_OFF = 0, RING_BYTES = 131072;
constexpr int LDSCTL_OFF = RING_BYTES;
constexpr int LDS_BYTES = 147456;
constexpr int NWAVES = 8;
constexpr int NPH = 8, NPHASES = 1 + DEPTH * NPH;

struct Args { const float* in[20]; float* out; unsigned char* ws; int ph_lo, ph_hi; };

#define FRESH() \
    unsigned char* ws = args.ws; asm volatile("" : "+s"(ws)); \
    int tid = threadIdx.x; asm volatile("" : "+v"(tid)); \
    const int lane = tid & 63, wave = __builtin_amdgcn_readfirstlane(tid >> 6); \
    const int gw = vcu * NWAVES + wave, NGW = G * NWAVES; \
    gu32* const ctl = (gu32*)(ws + WS_CTL); \
    bf16* const WIN = (bf16*)(ws + WS_WIN); bf16* const WOUT = (bf16*)(ws + WS_WOUT); bf16* const WUQ = (bf16*)(ws + WS_WUQ); bf16* const WUKV = (bf16*)(ws + WS_WUKV); \
    float* const COS = (float*)(ws + WS_COS); float* const SIN = (float*)(ws + WS_SIN); float* const BT = (float*)(ws + WS_BT); float* const WT = (float*)(ws + WS_WT); \
    bf16* const WGU = (bf16*)(ws + WS_WGU); bf16* const WD = (bf16*)(ws + WS_WD); \
    float* const XA = (float*)(ws + WS_XA); float* const X1 = (float*)(ws + WS_X1); bf16* const XB = (bf16*)(ws + WS_XB); \
    bf16* const H = (bf16*)(ws + WS_H); float* const Z = (float*)(ws + WS_Z); bf16* const HM = (bf16*)(ws + WS_HM); \
    bf16* const QC = (bf16*)(ws + WS_QC); bf16* const KC = (bf16*)(ws + WS_KC); bf16* const VC = (bf16*)(ws + WS_VC); bf16* const YS = (bf16*)(ws + WS_YS); \
    bf16* const OBG = (bf16*)(ws + WS_OBG); float* const LSE = (float*)(ws + WS_LSE); bf16* const OCAT = (bf16*)(ws + WS_OCAT); \
    int* const LTOK = (int*)(ws + WS_LTOK); float* const LW = (float*)(ws + WS_LW); int* const LDST = (int*)(ws + WS_LDST); \
    int* const TOKE = (int*)(ws + WS_TOKE); float* const TOKW = (float*)(ws + WS_TOKW); \
    float* const SSQ = (float*)(ws + WS_SSQ); \
    LAS float* const scr = (LAS float*)(lds + RING_OFF + wave * 16384); \
    (void)lane; (void)gw; (void)NGW; (void)ctl; (void)WIN; (void)WOUT; (void)WUQ; (void)WUKV; (void)COS; (void)SIN; (void)BT; (void)WT; (void)WGU; (void)WD; (void)XA; (void)X1; (void)XB; (void)H; (void)Z; (void)HM; (void)QC; (void)KC; (void)VC; (void)YS; (void)OBG; (void)LSE; (void)OCAT; (void)LTOK; (void)LW; (void)LDST; (void)TOKE; (void)TOKW; (void)SSQ; (void)scr;

__global__ void __launch_bounds__(NWAVES * 64, 2) mega_fwd(Args args) {
    extern __shared__ __attribute__((aligned(16))) unsigned char lds_raw[];
    LAS unsigned char* lds = (LAS unsigned char*)lds_raw;
    const int tid0 = threadIdx.x;
    const int G = gridDim.x; const int bx = blockIdx.x; const int vcu = (G % 8 == 0) ? (bx % 8) * (G / 8) + bx / 8 : bx;
    gu32* const ctl0 = (gu32*)(args.ws + WS_CTL);
    volatile LAS unsigned* LCTL = (volatile LAS unsigned*)(lds + LDSCTL_OFF);
    volatile LAS int* tstart = (volatile LAS int*)(lds + LDSCTL_OFF + 64);
    volatile LAS int* cnts = (volatile LAS int*)(lds + LDSCTL_OFF + 256);
    for (int u = tid0; u < (LDS_BYTES - LDSCTL_OFF) / 4; u += NWAVES * 64) LCTL[u] = 0u;
    __syncthreads();
    const int lo = args.ph_lo, hi = args.ph_hi;
    XcdBarrier bar; bar.bar = (unsigned*)(ctl0 + CW_BAR); bar.x = 0; bar.st = nullptr;
    if (hi - lo > 1) bar = xcd_barrier_post((unsigned*)(ctl0 + CW_BAR), LCTL);
#ifndef PH_MASK
#define PH_MASK 0x1ff
#endif
#define PHON(p) (((PH_MASK) >> (p)) & 1)
#ifndef PH_REPEAT
#define PH_REPEAT -1
#endif
#define REP(p) for (int rep_ = 0; rep_ < ((PH_REPEAT == (p)) ? 2 : 1); (++rep_, __syncthreads()))
#define IN(k) (lo <= (k) && (k) < hi)
#define SEAM(k) do { if (IN(k) && IN((k) + 1)) xcd_barrier(bar); } while (0)

    if (PHON(0) && IN(0)) REP(0) {
        FRESH();
        constexpr int I_WIN = 16 * 101, I_WOUT = 16 * 32, I_WUQ = 4 * 24, I_WUKV = 2 * 32, I_L = I_WIN + I_WOUT + I_WUQ + I_WUKV;
        for (int it = gw; it < DEPTH * I_L; it += NGW) {
            const int l = it / I_L; int r = it % I_L;
            if (r < I_WIN) { transpose_item(args.in[1] + (size_t)l * D * NIN, NIN, 64 * (r / 101), 32 * (r % 101), WIN + (size_t)l * NINP * D, D, 32 * (r % 101), nullptr, scr, lane); continue; } r -= I_WIN;
            if (r < I_WOUT) { transpose_item(args.in[2] + (size_t)l * D * D, D, 64 * (r / 32), 32 * (r % 32), WOUT + (size_t)l * D * D, D, 32 * (r % 32), nullptr, scr, lane); continue; } r -= I_WOUT;
            if (r < I_WUQ) { transpose_item(args.in[7] + (size_t)l * 256 * 768, 768, 64 * (r / 24), 32 * (r % 24), WUQ + (size_t)l * 768 * 256, 256, 32 * (r % 24), args.in[5] + l * 256, scr, lane); continue; } r -= I_WUQ;
            transpose_item(args.in[8] + (size_t)l * 128 * 1024, 1024, 64 * (r / 32), 32 * (r % 32), WUKV + (size_t)l * 1024 * 128, 128, 32 * (r % 32), args.in[6] + l * 128, scr, lane);
        }
        for (int it = gw; it < DEPTH * 96; it += NGW) {
            GAS v4u* p = (GAS v4u*)(WIN + ((size_t)(it / 96) * NINP + NIN + it % 96) * D);
            p[lane] = (v4u){0u, 0u, 0u, 0u}; p[lane + 64] = (v4u){0u, 0u, 0u, 0u};
        }
        for (int i = gw * 64 + lane; i < T * 16; i += NGW * 64) {
            const int t = i >> 4, j = i & 15;
            const float inv_freq = powf(10000.0f, -(float)(2 * j) / 32.0f);
            const float ang = (float)t * inv_freq;
            COS[i] = cosf(ang); SIN[i] = sinf(ang);
        }
        for (int i = gw * 64 + lane; i < 16 * 132; i += NGW * 64) {
            const int h = i / 132, d = i % 132; const int dil = h < 8 ? 1 : (h < 12 ? 4 : 16);
            BT[i] = args.in[4][t5_bucket(d * dil) * 16 + h] * LOG2E;
        }
        for (int i = gw * 64 + lane; i < DEPTH * 48 * D; i += NGW * 64) {
            const int l = i / (48 * D), c = (i / D) % 48, k = i % D;
            float v = 0.f;
            if (c < 4) v = args.in[11][((size_t)l * D + k) * 4 + c];
            else if (c < 36) v = args.in[13][(((size_t)l * 4 + ((c - 4) >> 3)) * D + k) * 8 + ((c - 4) & 7)];
            WT[i] = v;
        }
        for (int m = gw; m < T; m += NGW) {
            const GAS f32x4* xr = (const GAS f32x4*)(args.in[0] + (size_t)m * D) + lane; GAS v2u* o = (GAS v2u*)(XB + (size_t)m * D) + lane;
#pragma unroll
            for (int j = 0; j < 4; ++j) { const f32x4 v = xr[64 * j]; o[64 * j] = (v2u){pk2(v[0], v[1]), pk2(v[2], v[3])}; }
        }
    }
    SEAM(0);

    for (int layer = 0; layer < DEPTH; ++layer) {
        const int pb = 1 + layer * NPH;
        if (hi <= pb || lo >= pb + NPH) continue;

        if (PHON(1) && IN(pb + 0)) REP(1) {
            FRESH();
            pg8::Gemm g{XB, WIN + (size_t)layer * NINP * D, D, D, D}; pg8::StaticOrder S; S.init(T, NINP, G, bx);
            pg8::EpiGemm1 E{H, KC, SSQ, COS, SIN};
            pg8::gemm_phase<pg8::EpiGemm1, pg8::StaticOrder, true>(lds + RING_OFF, g, S, E);
        }
        SEAM(pb + 0);

        if (PHON(2) && IN(pb + 1)) REP(2) {
            FRESH();
#ifndef P2SUB
#define P2SUB 7
#endif
#ifndef P2REP
#define P2REP 7
#endif
#define P2ON(b) ((P2SUB & (b)) && (rep_ == 0 || (P2REP & (b))))
            if (P2ON(1)) { pg8::Gemm g{H + C_Q, WUQ + (size_t)layer * 768 * 256, NINP, 256, 256}; pg8::StaticOrder S; S.init(T, 768, G, bx);
              pg8::EpiUpQ E{QC, SSQ, COS, SIN};
              pg8::gemm_phase<pg8::EpiUpQ, pg8::StaticOrder, true>(lds + RING_OFF, g, S, E); }
            if (P2ON(2)) { pg8::Gemm g{H + C_KV, WUKV + (size_t)layer * 1024 * 128, NINP, 128, 128}; pg8::StaticOrder S; S.init(T, 1024, G, bx);
              pg8::EpiUpKV E{KC, VC, SSQ};
              pg8::gemm_phase<pg8::EpiUpKV, pg8::StaticOrder, true>(lds + RING_OFF, g, S, E); }
            if (P2ON(4)) {
                LAS float* btx = (LAS float*)(lds + LDSCTL_OFF + 1024);
                __syncthreads();
                for (int i = tid; i < 16 * 192; i += NWAVES * 64) { const int h = i / 192, d = i % 192 - 31; const int Wh = h < 4 ? 127 : 128;
                    btx[i] = (d >= 0 && d <= Wh) ? BT[h * 132 + d] : -INFINITY; }
                __syncthreads();
                LAS unsigned char* wl = lds + RING_OFF + wave * att::BAND_WLDS;
                for (int it = gw; it < 16 * 512; it += NGW) {
                    const int h16 = it >> 9, blk = it & 511;
                    att::BandP a;
                    if (h16 < 4) {
                        a.Q = H + A_Q + h16 * 64; a.K = H + A_K + (h16 >> 1) * 64; a.V = H + A_V + (h16 >> 1) * 64; a.str = NINP;
                        a.O = OCAT + h16 * 64; a.ostr = 1024; a.LSE = nullptr; a.lstr = 0; a.qa = blk * 32;
                        a.m_init = args.in[3][layer * 4 + h16] * LOG2E; a.l_init = 1.0f;
                    } else {
                        const int hb = h16 - 4, g = hb >> 2; const int dil = g == 0 ? 1 : (g == 1 ? 4 : 16);
                        const int nblk = (T / dil) / 32; const int r = blk / nblk;
                        a.Q = H + (size_t)r * NINP + B_Q + hb * 64; a.K = H + (size_t)r * NINP + B_K + hb * 64; a.V = H + (size_t)r * NINP + B_V + hb * 64; a.str = (long)dil * NINP;
                        a.O = OBG + (size_t)r * 768 + hb * 64; a.ostr = (long)dil * 768; a.LSE = LSE + (size_t)r * 12 + hb; a.lstr = (long)dil * 12; a.qa = (blk % nblk) * 32;
                        a.m_init = -INFINITY; a.l_init = 0.f;
                    }
                    att::band_item(a, btx + h16 * 192, wl);
                }
            }
        }
        SEAM(pb + 1);

        if (PHON(3) && IN(pb + 2)) REP(3) {
            FRESH();
            for (int t = gw; t < T; t += NGW) {
                const int hh = lane >> 4, d4 = (lane & 15) * 4;
                float l3[3], w3[3];
#pragma unroll
                for (int g = 0; g < 3; ++g) l3[g] = LSE[(size_t)t * 12 + g * 4 + hh];
                const float mx = fmaxf(fmaxf(l3[0], l3[1]), l3[2]);
                float s = 0.f;
#pragma unroll
                for (int g = 0; g < 3; ++g) { w3[g] = __builtin_amdgcn_exp2f(l3[g] - mx); s += w3[g]; }
                const float inv = 1.0f / s; float o[4] = {0.f, 0.f, 0.f, 0.f};
#pragma unroll
                for (int g = 0; g < 3; ++g) { const v2u w = *(const GAS v2u*)(OBG + (size_t)t * 768 + (g * 4 + hh) * 64 + d4); const float wg = w3[g] * inv;
                    o[0] += wg * bf2f((bf16)(w.x & 0xffffu)); o[1] += wg * bf2f((bf16)(w.x >> 16)); o[2] += wg * bf2f((bf16)(w.y & 0xffffu)); o[3] += wg * bf2f((bf16)(w.y >> 16)); }
                *(GAS v2u*)(OCAT + (size_t)t * 1024 + 256 + hh * 64 + d4) = (v2u){pk2(o[0], o[1]), pk2(o[2], o[3])};
            }
            for (int p = vcu; p < 256; p += G) {
                const int head = p >> 5, s = p & 31;
#pragma unroll 1
                for (int k = 0; k < 2; ++k) {
                    const int qb = k == 0 ? s : 63 - s;
                    att::AttnP a;
                    a.Q = QC + head * 96; a.qstr = 768; a.K = KC + head * 96; a.kstr = 768; a.V = VC + head * 64; a.vstr = 512;
                    a.O = OCAT + 512 + head * 64; a.ostr = 1024; a.LSE = nullptr; a.lstr = 0; a.W = 0;
                    a.q0 = qb * 256; a.k0 = 0; a.nt = (a.q0 + 256) / 64; a.m_init = -INFINITY; a.l_init = 0.f;
                    att::attn_unit_mla(a, lds + RING_OFF);
                }
            }
        }
        SEAM(pb + 2);

        if (PHON(4) && IN(pb + 3)) REP(4) {
            FRESH();
            pg8::Gemm g{OCAT, WOUT + (size_t)layer * D * D, D, D, D}; pg8::StaticOrder S; S.init(T, D, G, bx);
            pg8::EpiOut E{XB, Z};
            pg8::gemm_phase<pg8::EpiOut, pg8::StaticOrder, true>(lds + RING_OFF, g, S, E);
        }
        SEAM(pb + 3);

        if (PHON(5) && IN(pb + 4)) {
            FRESH();
            const float* wg = args.in[15] + (size_t)layer * NEXP * D * DEXP; const float* wu = args.in[16] + (size_t)layer * NEXP * D * DEXP; const float* wd = args.in[17] + (size_t)layer * NEXP * DEXP * D;
            REP(5) for (int it = gw; it < 3 * 4096; it += NGW) {
                const int which = it >> 12, r = it & 4095, e = r >> 7, q = r & 127;
                if (which < 2) { const int kb = q >> 3, nb = q & 7;
                    transpose_item((which == 0 ? wg : wu) + (size_t)e * D * DEXP, DEXP, 64 * kb, 32 * nb, WGU + (size_t)e * 512 * D, D, (nb >> 2) * 256 + which * 128 + (nb & 3) * 32, nullptr, scr, lane);
                } else { const int kb = q >> 5, nb = q & 31;
                    transpose_item(wd + (size_t)e * DEXP * D, D, 64 * kb, 32 * nb, WD + (size_t)e * D * DEXP, DEXP, 32 * nb, nullptr, scr, lane); }
            }
            __syncthreads();
            LAS int* row_e = (LAS int*)(lds + RING_OFF); LAS float* row_w = (LAS float*)(lds + RING_OFF + 512); LAS int* row_p = (LAS int*)(lds + RING_OFF + 1024);
            LAS int* lcnt = (LAS int*)(lds + RING_OFF + 1536); LAS int* lbase = (LAS int*)(lds + RING_OFF + 1664);
            const float* g1 = args.in[9] + layer * D; const float* b1 = args.in[10] + layer * D;
            f32x4 gv[4], bv[4];
#pragma unroll
            for (int j = 0; j < 4; ++j) { gv[j] = *(const GAS f32x4*)(g1 + 256 * j + 4 * lane); bv[j] = *(const GAS f32x4*)(b1 + 256 * j + 4 * lane); }
            LAS float* part = (LAS float*)(lds + RING_OFF + 2048);
            const float* WTl = WT + (size_t)layer * 48 * D;
            for (int rb = vcu; rb < T / 64; rb += G) {
                if (tid < 32) lcnt[tid] = 0;
                for (int i = 0; i < 8; ++i) {
                    const int rl = wave * 8 + i, row = rb * 64 + rl;
                    const GAS f32x4* zr = (const GAS f32x4*)(Z + (size_t)row * D) + lane;
                    f32x4 v[4]; float s = 0.f;
#pragma unroll
                    for (int j = 0; j < 4; ++j) { v[j] = zr[64 * j]; s += (v[j][0] + v[j][1]) + (v[j][2] + v[j][3]); }
                    const float mean = wave_sum(s) * (1.f / D); float s2 = 0.f;
#pragma unroll
                    for (int j = 0; j < 4; ++j) { v[j] = v[j] - mean; s2 += (v[j][0] * v[j][0] + v[j][1] * v[j][1]) + (v[j][2] * v[j][2] + v[j][3] * v[j][3]); }
                    const float rstd = 1.f / sqrtf(wave_sum(s2) * (1.f / D) + 1e-5f);
                    GAS f32x4* xo = (GAS f32x4*)(X1 + (size_t)row * D) + lane; GAS v2u* xb = (GAS v2u*)(XB + (size_t)row * D) + lane;
#pragma unroll
                    for (int j = 0; j < 4; ++j) { v[j] = v[j] * rstd * gv[j] + bv[j]; xo[64 * j] = v[j]; xb[64 * j] = (v2u){pk2(v[j][0], v[j][1]), pk2(v[j][2], v[j][3])}; }
                }
                VM_WAIT();
                __syncthreads();
                { const int task = wave >> 1, kh = wave & 1, r16 = lane & 15, q = lane >> 4;
                  const GAS f32x4* ap = (const GAS f32x4*)(X1 + (size_t)(rb * 64 + task * 16 + r16) * D + kh * 512 + 4 * q);
                  const GAS f32x4* bp = (const GAS f32x4*)(WTl + (size_t)r16 * D + kh * 512 + 4 * q);
                  f32x4 c0 = {0.f, 0.f, 0.f, 0.f}, c1 = c0, c2 = c0;
#pragma unroll 4
                  for (int j = 0; j < 32; ++j) {
                      const f32x4 av = ap[4 * j], b0 = bp[4 * j], b1 = bp[4 * j + 16 * D / 4], b2 = bp[4 * j + 32 * D / 4];
#pragma unroll
                      for (int i = 0; i < 4; ++i) { c0 = __builtin_amdgcn_mfma_f32_16x16x4f32(av[i], b0[i], c0, 0, 0, 0); c1 = __builtin_amdgcn_mfma_f32_16x16x4f32(av[i], b1[i], c1, 0, 0, 0); c2 = __builtin_amdgcn_mfma_f32_16x16x4f32(av[i], b2[i], c2, 0, 0, 0); }
                  }
                  LAS float* pp = part + (size_t)(kh * 64 + task * 16 + 4 * q) * 49 + r16;
#pragma unroll
                  for (int i = 0; i < 4; ++i) { pp[i * 49] = c0[i]; pp[i * 49 + 16] = c1[i]; pp[i * 49 + 32] = c2[i]; } }
                __syncthreads();
                if (tid < 64) {
                    const LAS float* p0 = part + tid * 49; const LAS float* p1 = part + (64 + tid) * 49;
                    const float* brg = args.in[12] + layer * 4; const float* bre = args.in[14] + layer * 32;
                    float g[4];
#pragma unroll
                    for (int k = 0; k < 4; ++k) g[k] = (p0[k] + p1[k]) + brg[k];
                    int grp = 0; float gm = g[0];
#pragma unroll
                    for (int k = 1; k < 4; ++k) if (g[k] > gm) { gm = g[k]; grp = k; }
                    float gs = 0.f;
#pragma unroll
                    for (int k = 0; k < 4; ++k) gs += expf(g[k] - gm);
                    const float pgrp = 1.0f / gs;
                    float e[8];
#pragma unroll
                    for (int k = 0; k < 8; ++k) e[k] = (p0[4 + grp * 8 + k] + p1[4 + grp * 8 + k]) + bre[grp * 8 + k];
                    int i0 = 0; float v0 = e[0];
#pragma unroll
                    for (int k = 1; k < 8; ++k) if (e[k] > v0) { v0 = e[k]; i0 = k; }
                    int i1 = -1; float v1 = -INFINITY;
#pragma unroll
                    for (int k = 0; k < 8; ++k) if (k != i0 && e[k] > v1) { v1 = e[k]; i1 = k; }
                    const float tt = expf(v1 - v0);
                    const int e0 = grp * 8 + i0, e1 = grp * 8 + i1;
                    row_e[tid * 2] = e0; row_e[tid * 2 + 1] = e1; row_w[tid * 2] = pgrp / (1.0f + tt); row_w[tid * 2 + 1] = pgrp * tt / (1.0f + tt);
                    row_p[tid * 2] = __hip_atomic_fetch_add(&lcnt[e0], 1, __ATOMIC_RELAXED, __HIP_MEMORY_SCOPE_WORKGROUP);
                    row_p[tid * 2 + 1] = __hip_atomic_fetch_add(&lcnt[e1], 1, __ATOMIC_RELAXED, __HIP_MEMORY_SCOPE_WORKGROUP);
                }
                __syncthreads();
                if (tid < 32) lbase[tid] = (int)__hip_atomic_fetch_add(ctl + CW_CNT + layer * 32 + tid, (unsigned)lcnt[tid], RLX_AGENT);
                __syncthreads();
                if (tid < 128) { const int rl = tid >> 1, k = tid & 1, row = rb * 64 + rl; const int e = row_e[tid]; const int idx = lbase[e] + row_p[tid]; const float w = row_w[tid];
                    LTOK[(size_t)e * T + idx] = row; LW[(size_t)e * T + idx] = w; LDST[(size_t)e * T + idx] = 2 * row + k; TOKE[2 * row + k] = e; TOKW[2 * row + k] = w; }
                __syncthreads();
            }
        }
        SEAM(pb + 4);

        if ((PHON(6) || PHON(7)) && (IN(pb + 5) || IN(pb + 6))) {
            FRESH();
            if (tid < 32) cnts[tid] = (int)__hip_atomic_load(ctl + CW_CNT + layer * 32 + tid, RLX_AGENT);
            __syncthreads();
            if (tid == 0) { int acc = 0; for (int e = 0; e < 32; ++e) { tstart[e] = acc; acc += (cnts[e] + 255) >> 8; } tstart[32] = acc; }
            __syncthreads();
        }
        if (PHON(6) && IN(pb + 5)) REP(6) {
            FRESH();
            pg8::MoeOrder S; S.tstart = tstart; S.cnts = cnts; S.list_tok = LTOK; S.npn = 2; S.G = G; S.c = vcu;
            pg8::Gemm g{XB, WGU, D, D, D}; pg8::EpiMoe1 E{HM};
            pg8::gemm_phase<pg8::EpiMoe1, pg8::MoeOrder, true>(lds + RING_OFF, g, S, E);
        }
        SEAM(pb + 5);
        if (PHON(7) && IN(pb + 6)) REP(7) {
            FRESH();
            pg8::MoeOrderDense S; S.tstart = tstart; S.cnts = cnts; S.list_tok = LTOK; S.npn = 4; S.G = G; S.c = vcu;
            pg8::Gemm g{HM, WD, DEXP, DEXP, DEXP}; pg8::EpiMoe2 E{YS, LDST, LW, cnts};
            pg8::gemm_phase<pg8::EpiMoe2, pg8::MoeOrderDense, true>(lds + RING_OFF, g, S, E);
        }
        SEAM(pb + 6);

        if (PHON(8) && IN(pb + 7)) REP(8) {
            FRESH();
            const bool lastl = layer == DEPTH - 1;
            const float* g2 = args.in[18] + layer * D; const float* b2 = args.in[19] + layer * D;
            f32x4 gv[4], bv[4];
#pragma unroll
            for (int j = 0; j < 4; ++j) { gv[j] = *(const GAS f32x4*)(g2 + 256 * j + 4 * lane); bv[j] = *(const GAS f32x4*)(b2 + 256 * j + 4 * lane); }
            for (int row = gw; row < T; row += NGW) {
                const GAS v2u* xr = (const GAS v2u*)(XB + (size_t)row * D) + lane;
                const GAS v2u* y0 = (const GAS v2u*)(YS + (size_t)(2 * row) * D) + lane; const GAS v2u* y1 = (const GAS v2u*)(YS + (size_t)(2 * row + 1) * D) + lane;
                f32x4 v[4]; float s = 0.f;
#pragma unroll
                for (int j = 0; j < 4; ++j) { const v2u x = xr[64 * j]; const v2u a = y0[64 * j], b = y1[64 * j];
                    v[j][0] = bf2f((bf16)(x.x & 0xffffu)) * ALPHA + (bf2f((bf16)(a.x & 0xffffu)) + bf2f((bf16)(b.x & 0xffffu))); v[j][1] = bf2f((bf16)(x.x >> 16)) * ALPHA + (bf2f((bf16)(a.x >> 16)) + bf2f((bf16)(b.x >> 16)));
                    v[j][2] = bf2f((bf16)(x.y & 0xffffu)) * ALPHA + (bf2f((bf16)(a.y & 0xffffu)) + bf2f((bf16)(b.y & 0xffffu))); v[j][3] = bf2f((bf16)(x.y >> 16)) * ALPHA + (bf2f((bf16)(a.y >> 16)) + bf2f((bf16)(b.y >> 16)));
                    s += (v[j][0] + v[j][1]) + (v[j][2] + v[j][3]); }
                const float mean = wave_sum(s) * (1.f / D); float s2 = 0.f;
#pragma unroll
                for (int j = 0; j < 4; ++j) { v[j] = v[j] - mean; s2 += (v[j][0] * v[j][0] + v[j][1] * v[j][1]) + (v[j][2] * v[j][2] + v[j][3] * v[j][3]); }
                const float rstd = 1.f / sqrtf(wave_sum(s2) * (1.f / D) + 1e-5f);
                GAS f32x4* xo = (GAS f32x4*)(args.out + (size_t)row * D) + lane; GAS v2u* xb = (GAS v2u*)(XB + (size_t)row * D) + lane;
#pragma unroll
                for (int j = 0; j < 4; ++j) { v[j] = v[j] * rstd * gv[j] + bv[j]; if (lastl) xo[64 * j] = v[j]; else xb[64 * j] = (v2u){pk2(v[j][0], v[j][1]), pk2(v[j][2], v[j][3])}; }
            }
        }
        SEAM(pb + 7);
    }
#undef IN
#undef SEAM
}
#define DBG_AFTER_PHASE(ph) do {} while (0)
#define DBG_FINISH() do {} while (0)
#ifndef MK_MULTI
#define MK_MULTI 0
#endif
extern "C" void kernel_launch(void* const* d_in, const int* in_sizes, int n_in, void* d_out, int out_size, void* d_ws, size_t ws_size, hipStream_t stream) {
    static int grid = 0;
    if (grid == 0) {
        if (n_in != 20 || in_sizes[0] != T * D || out_size != T * D || ws_size < WS_END) { fprintf(stderr, "kernel_launch: unexpected problem shape / workspace (%d inputs, ws %zu)\n", n_in, ws_size); grid = -1; return; }
        int dev = 0, cus = 0, per_cu = 0;
        if (hipGetDevice(&dev) != hipSuccess || hipDeviceGetAttribute(&cus, hipDeviceAttributeMultiprocessorCount, dev) != hipSuccess) { grid = -1; return; }
        if (hipFuncSetAttribute((const void*)mega_fwd, hipFuncAttributeMaxDynamicSharedMemorySize, LDS_BYTES) != hipSuccess) { fprintf(stderr, "kernel_launch: hipFuncSetAttribute failed\n"); grid = -1; return; }
        if (hipOccupancyMaxActiveBlocksPerMultiprocessor(&per_cu, (const void*)mega_fwd, NWAVES * 64, LDS_BYTES) != hipSuccess || per_cu < 1) { fprintf(stderr, "kernel_launch: occupancy query says %d\n", per_cu); }
        (void)hipGetLastError();
        grid = cus;
    }
    if (grid < 0) return;
    (void)hipMemsetAsync((char*)d_ws + WS_CTL, 0, CTL_ZERO_BYTES, stream);
    Args a{};
    for (int i = 0; i < 20; ++i) a.in[i] = (const float*)d_in[i];
    a.out = (float*)d_out; a.ws = (unsigned char*)d_ws;
#if MK_MULTI
    for (int ph = 0; ph < NPHASES; ++ph) {
        a.ph_lo = ph; a.ph_hi = ph + 1;
        hipLaunchKernelGGL(mega_fwd, dim3(grid), dim3(NWAVES * 64), LDS_BYTES, stream, a);
        DBG_AFTER_PHASE(ph);
    }
    DBG_FINISH();
#else
    a.ph_lo = 0; a.ph_hi = NPHASES;
    hipLaunchKernelGGL(mega_fwd, dim3(grid), dim3(NWAVES * 64), LDS_BYTES, stream, a);
#endif
}
```
